# Optimizing an MI355X kernel written in HIP

```python
import math
import jax, jax.numpy as jnp
from jax import lax
import numpy as np

D_MODEL = 1024
BATCH = 8
SEQ = 4096
DEPTH = 2

GDN_HEADS = 4
GDN_HEAD_DIM = 128
GDN_WIDTH = GDN_HEADS * GDN_HEAD_DIM
CONV_WIDTH = 4
CHUNK = 64
SWA_HEADS = 8
SWA_HEAD_DIM = 64
SWA_WIDTH = SWA_HEADS * SWA_HEAD_DIM
DILATED_CONFIGS = ((128, 1), (512, 4), (2048, 16))
BAND_BLOCK = 128
MIX_WIDTH = GDN_WIDTH + SWA_WIDTH
IN_SIZES = (3 * GDN_WIDTH, GDN_WIDTH, GDN_HEADS, GDN_HEADS, SWA_WIDTH, SWA_WIDTH, SWA_WIDTH)
IN_COLS = sum(IN_SIZES)
IN_SPLITS = tuple(int(c) for c in np.cumsum(IN_SIZES)[:-1])
D_FF = 2816
FFN_CONV_WIDTH = 3
RMS_EPS = 1e-6
L2_EPS = 1e-6

kernel_name = 'hybrid_gdn_dilated_alibi_convffn'


def rmsnorm(x, gain):
    xf = x.astype(jnp.float32)
    y = xf * lax.rsqrt(jnp.mean(xf * xf, axis=-1, keepdims=True) + RMS_EPS)
    return (y * gain.astype(jnp.float32)).astype(x.dtype)


def l2norm(x):
    xf = x.astype(jnp.float32)
    return xf * lax.rsqrt(jnp.sum(xf * xf, axis=-1, keepdims=True) + L2_EPS)


def causal_dwconv(x, w):
    k_width = w.shape[0]
    s = x.shape[1]
    xp = jnp.pad(x, ((0, 0), (k_width - 1, 0), (0, 0)))
    return sum(xp[:, j:j + s] * w[j] for j in range(k_width))


def alibi_slopes(n_heads):
    return jnp.asarray(2.0 ** (-8.0 * np.arange(1, n_heads + 1) / n_heads), dtype=jnp.float32)


def chunk_gated_delta_rule(q, k, v, g, beta):
    bn, h, s, dk = q.shape
    dv = v.shape[-1]
    n = s // CHUNK
    q = q * dk ** -0.5
    q = q.reshape(bn, h, n, CHUNK, dk)
    k = k.reshape(bn, h, n, CHUNK, dk)
    v = v.reshape(bn, h, n, CHUNK, dv)
    beta = beta.reshape(bn, h, n, CHUNK, 1)
    g = jnp.cumsum(g.reshape(bn, h, n, CHUNK), axis=-1)
    idx = jnp.arange(CHUNK)
    causal = idx[:, None] >= idx[None, :]
    strict = idx[:, None] > idx[None, :]
    decay = jnp.exp(jnp.where(causal, g[..., :, None] - g[..., None, :], -jnp.inf))
    k_beta = k * beta
    a = jnp.where(strict, jnp.einsum('bhnik,bhnjk->bhnij', k_beta, k) * decay, 0.0)
    rhs = jnp.concatenate([v * beta, k_beta * jnp.exp(g)[..., None]], axis=-1)
    sol = lax.linalg.triangular_solve(a, rhs, left_side=True, lower=True, unit_diagonal=True)
    u, w = sol[..., :dv], sol[..., dv:]
    a_qk = jnp.where(causal, jnp.einsum('bhnik,bhnjk->bhnij', q, k) * decay, 0.0)
    q_dec = q * jnp.exp(g)[..., None]
    g_last = g[..., -1:]
    k_dec = k * jnp.exp(g_last - g)[..., None]
    decay_last = jnp.exp(g_last[..., 0])

    def step(state, inp):
        qd, wc, uc, kd, aqk, dl = inp
        v_new = uc - jnp.einsum('bhik,bhkv->bhiv', wc, state)
        o = jnp.einsum('bhik,bhkv->bhiv', qd, state) + jnp.einsum('bhij,bhjv->bhiv', aqk, v_new)
        state = state * dl[..., None, None] + jnp.einsum('bhik,bhiv->bhkv', kd, v_new)
        return state, o

    xs = tuple(jnp.moveaxis(t, 2, 0) for t in (q_dec, w, u, k_dec, a_qk, decay_last))
    state0 = jnp.zeros((bn, h, dk, dv), jnp.float32)
    _, o = lax.scan(step, state0, xs)
    return jnp.moveaxis(o, 0, 2).reshape(bn, h, s, dv)


def gated_deltanet(qkv, z, b_logit, a_logit, conv_w, a_log, dt_bias, norm_gain):
    bn, s, _ = qkv.shape
    out_dtype = z.dtype
    qkv = jax.nn.silu(causal_dwconv(qkv, conv_w))
    q, k, v = jnp.split(qkv, 3, axis=-1)
    heads = lambda t: t.reshape(bn, s, GDN_HEADS, GDN_HEAD_DIM).transpose(0, 2, 1, 3)
    q = l2norm(heads(q))
    k = l2norm(heads(k))
    v = heads(v).astype(jnp.float32)
    beta = jax.nn.sigmoid(b_logit.astype(jnp.float32)).transpose(0, 2, 1)
    g = (-jnp.exp(a_log.astype(jnp.float32))
         * jax.nn.softplus(a_logit.astype(jnp.float32) + dt_bias.astype(jnp.float32))).transpose(0, 2, 1)
    o = chunk_gated_delta_rule(q, k, v, g, beta).transpose(0, 2, 1, 3)
    zf = z.reshape(bn, s, GDN_HEADS, GDN_HEAD_DIM).astype(jnp.float32)
    y = (o * lax.rsqrt(jnp.mean(o * o, axis=-1, keepdims=True) + RMS_EPS)
         * norm_gain.astype(jnp.float32) * jax.nn.silu(zf))
    return y.reshape(bn, s, GDN_WIDTH).astype(out_dtype)


def banded_causal_attention(q, k, v, n_back, step, slopes):
    nb, h, l, dh = q.shape
    nblk = -(-l // BAND_BLOCK)
    lp = nblk * BAND_BLOCK
    qb = jnp.pad(q, ((0, 0), (0, 0), (0, lp - l), (0, 0))).reshape(nb, h, nblk, BAND_BLOCK, dh)

    def band(t):
        tp = jnp.pad(t, ((0, 0), (0, 0), (BAND_BLOCK, lp - l), (0, 0)))
        prev = tp[:, :, :lp].reshape(nb, h, nblk, BAND_BLOCK, dh)
        cur = tp[:, :, BAND_BLOCK:].reshape(nb, h, nblk, BAND_BLOCK, dh)
        return jnp.concatenate([prev, cur], axis=3)

    kb, vb = band(k), band(v)
    s = jnp.einsum('nhbqd,nhbkd->nhbqk', qb, kb).astype(jnp.float32) * dh ** -0.5
    qi = jnp.arange(BAND_BLOCK)[:, None]
    kj = jnp.arange(2 * BAND_BLOCK)[None, :]
    dist = qi + BAND_BLOCK - kj
    key_pos = (jnp.arange(nblk) * BAND_BLOCK - BAND_BLOCK)[:, None, None] + kj
    valid = (dist >= 0) & (dist <= n_back) & (key_pos >= 0)
    alibi = -slopes[:, None, None, None] * (dist * step).astype(jnp.float32)
    s = jnp.where(valid, s + alibi, -jnp.inf)
    m = jnp.max(s, axis=-1, keepdims=True)
    p = jnp.exp(s - m)
    den = jnp.sum(p, axis=-1, keepdims=True)
    o = jnp.einsum('nhbqk,nhbkd->nhbqd', p, vb.astype(jnp.float32)) / den
    lse = (m + jnp.log(den))[..., 0]
    return o.reshape(nb, h, lp, dh)[:, :, :l], lse.reshape(nb, h, lp)[:, :, :l]


def dilated_attention(q, k, v, slopes):
    bn, s, h, dh = q.shape
    outs, lses = [], []
    for window, dilation in DILATED_CONFIGS:
        l = s // dilation
        sub = lambda t: t.reshape(bn, l, dilation, h, dh).transpose(0, 2, 3, 1, 4).reshape(bn * dilation, h, l, dh)
        o, lse = banded_causal_attention(sub(q), sub(k), sub(v), window // dilation, dilation, slopes)
        outs.append(o.reshape(bn, dilation, h, l, dh).transpose(0, 3, 1, 2, 4).reshape(bn, s, h, dh))
        lses.append(lse.reshape(bn, dilation, h, l).transpose(0, 3, 1, 2).reshape(bn, s, h))
    weights = jax.nn.softmax(jnp.stack(lses), axis=0)
    return jnp.einsum('gbsh,gbshd->bshd', weights, jnp.stack(outs))


def setup_inputs(seed: int = 0) -> dict:
    key = jax.random.key(seed)
    ks = jax.random.split(key, 16)
    nrm = lambda kk, shape, fan_in: jax.random.normal(kk, shape, jnp.float32) * fan_in ** -0.5
    x = jax.random.normal(ks[0], (BATCH, SEQ, D_MODEL), jnp.float32)
    ln1 = 1.0 + 0.02 * jax.random.normal(ks[1], (DEPTH, D_MODEL), jnp.float32)
    w_in = nrm(ks[2], (DEPTH, D_MODEL, IN_COLS), D_MODEL)
    conv_qkv = nrm(ks[3], (DEPTH, CONV_WIDTH, 3 * GDN_WIDTH), CONV_WIDTH)
    a_log = jnp.log(jax.random.uniform(ks[4], (DEPTH, GDN_HEADS), jnp.float32, minval=1.0, maxval=16.0))
    dt = jnp.exp(jax.random.uniform(ks[5], (DEPTH, GDN_HEADS), jnp.float32,
                                    minval=math.log(1e-3), maxval=math.log(1e-1)))
    dt_bias = jnp.log(jnp.expm1(dt))
    gdn_norm = 1.0 + 0.02 * jax.random.normal(ks[6], (DEPTH, GDN_HEAD_DIM), jnp.float32)
    w_out = nrm(ks[7], (DEPTH, MIX_WIDTH, D_MODEL), MIX_WIDTH)
    ln2 = 1.0 + 0.02 * jax.random.normal(ks[8], (DEPTH, D_MODEL), jnp.float32)
    w_gate = nrm(ks[9], (DEPTH, D_MODEL, D_FF), D_MODEL)
    w_up = nrm(ks[10], (DEPTH, D_MODEL, D_FF), D_MODEL)
    ffn_conv = nrm(ks[11], (DEPTH, FFN_CONV_WIDTH, D_FF), FFN_CONV_WIDTH)
    w_down = nrm(ks[12], (DEPTH, D_FF, D_MODEL), D_FF)
    ln_f = 1.0 + 0.02 * jax.random.normal(ks[13], (D_MODEL,), jnp.float32)
    return {'x': x, 'ln1': ln1, 'w_in': w_in, 'conv_qkv': conv_qkv, 'a_log': a_log, 'dt_bias': dt_bias,
            'gdn_norm': gdn_norm, 'w_out': w_out, 'ln2': ln2, 'w_gate': w_gate, 'w_up': w_up,
            'ffn_conv': ffn_conv, 'w_down': w_down, 'ln_f': ln_f}


def reference(x, ln1, w_in, conv_qkv, a_log, dt_bias, gdn_norm, w_out, ln2, w_gate, w_up, ffn_conv, w_down, ln_f):
    bn, s, _ = x.shape
    slopes = alibi_slopes(SWA_HEADS)
    heads_b = lambda t: t.reshape(bn, s, SWA_HEADS, SWA_HEAD_DIM)
    for l in range(DEPTH):
        h = rmsnorm(x, ln1[l])
        proj = h @ w_in[l]
        qkv_a, z_a, b_a, a_a, q_b, k_b, v_b = jnp.split(proj, IN_SPLITS, axis=-1)
        y_a = gated_deltanet(qkv_a, z_a, b_a, a_a, conv_qkv[l], a_log[l], dt_bias[l], gdn_norm[l])
        y_b = dilated_attention(heads_b(q_b), heads_b(k_b), heads_b(v_b), slopes)
        y_b = y_b.reshape(bn, s, SWA_WIDTH).astype(x.dtype)
        x = x + jnp.concatenate([y_a, y_b], axis=-1) @ w_out[l]
        h = rmsnorm(x, ln2[l])
        gate = causal_dwconv(h @ w_gate[l], ffn_conv[l])
        x = x + (jax.nn.silu(gate) * (h @ w_up[l])) @ w_down[l]
    return rmsnorm(x, ln_f)
```

```cpp
#include <hip/hip_runtime.h>
#include <hip/hip_cooperative_groups.h>
#include <cstdio>
#include <cstdint>
namespace cg = cooperative_groups;

namespace pg8 {
#define PG8_LAS __attribute__((address_space(3)))
typedef unsigned short bf16_t;
typedef short bf16x8 __attribute__((ext_vector_type(8)));
typedef float f32x4 __attribute__((ext_vector_type(4)));
typedef unsigned u32x4 __attribute__((ext_vector_type(4)));
constexpr int BM = 256, BK = 64, HALF = 128, HTB = HALF * BK * 2  , STAGE_BYTES = 8 * HTB, NXCD = 8;
#ifndef PG8_WGM
#define PG8_WGM 8
#endif
constexpr int WGM = PG8_WGM;

__host__ __device__ __forceinline__ int lds_byte(int r, int c) { const int st = (r >> 4) * 2 + (c >> 5), rr = r & 15, cc = c & 31, ob = rr * 64 + cc * 2; return st * 1024 + (ob ^ (((ob >> 9) & 1) << 5)); }
__host__ __device__ __forceinline__ void stage_rc(int b, int& R, int& C) { const int st = b / 1024, sb = b % 1024, swz = sb ^ (((sb >> 9) & 1) << 5); R = (st >> 1) * 16 + swz / 64; C = (st & 1) * 32 + (swz % 64) / 2; }
__host__ __device__ __forceinline__ int perm32(int rho) { const int n = rho >> 4, i = rho & 15; return 8 * (i >> 2) + 4 * n + (i & 3); }

typedef unsigned long long ssq_t;
__device__ __forceinline__ ssq_t ssq_pack(float s) { return (ssq_t)(s * 1048576.0f); }
__device__ __forceinline__ float ssq_val(ssq_t q) { return (float)(unsigned)(q >> 20) + (float)((unsigned)q & 0xfffffu) * (1.0f / 1048576.0f); }
struct Unit { int pm, pn; };
struct Gemm { const bf16_t* A; const bf16_t* Bt; int M, N, K; };

struct StaticOrder {
    int nM, nN, nwg, G, c;
    __host__ __device__ void init(int M, int N, int G_, int c_) { nM = M / BM; nN = N / BM; nwg = nM * nN; G = G_; c = c_; }
    __host__ __device__ bool next(int i, Unit& u) const {
        const long L = (long)i * G + c; if (L >= nwg) return false;
        int wgid = (int)L; { const int q = nwg / NXCD, r = nwg % NXCD, xcd = wgid % NXCD, off = wgid / NXCD; wgid = (xcd < r ? xcd * (q + 1) : r * (q + 1) + (xcd - r) * q) + off; }
        const int nig = WGM * nN, gid = wgid / nig, fm = gid * WGM, gsz = (nM - fm) < WGM ? (nM - fm) : WGM;
        u.pm = fm + ((wgid % nig) % gsz); u.pn = (wgid % nig) / gsz; return true;
    }
    __device__ __forceinline__ void a_ready(const Unit&) const {}
    __device__ __forceinline__ void done(const Unit&) const {}
};


typedef __bf16 bf16v2_t __attribute__((ext_vector_type(2)));
typedef float f32v2_t __attribute__((ext_vector_type(2)));
__device__ __forceinline__ unsigned cvt_pk_bf16(float lo, float hi) { const f32v2_t v = {lo, hi}; return __builtin_bit_cast(unsigned, __builtin_convertvector(v, bf16v2_t)); }
typedef unsigned u32x2 __attribute__((ext_vector_type(2)));
constexpr float RMS_EPS = 1e-6f;
constexpr int SIDE_OFF = 143360, SIDE_BYTES = 8192, SIDE_SSQ = 6144  ;

__device__ __forceinline__ float dpp_ror1(float v) { return __builtin_bit_cast(float, __builtin_amdgcn_update_dpp(0, __builtin_bit_cast(int, v), 0x121, 0xf, 0xf, false)); }
__device__ __forceinline__ float dpp_ror2(float v) { return __builtin_bit_cast(float, __builtin_amdgcn_update_dpp(0, __builtin_bit_cast(int, v), 0x122, 0xf, 0xf, false)); }
__device__ __forceinline__ f32x4 ror1v(f32x4 v) { return (f32x4){dpp_ror1(v[0]), dpp_ror1(v[1]), dpp_ror1(v[2]), dpp_ror1(v[3])}; }
__device__ __forceinline__ f32x4 ror2v(f32x4 v) { return (f32x4){dpp_ror2(v[0]), dpp_ror2(v[1]), dpp_ror2(v[2]), dpp_ror2(v[3])}; }
__device__ __forceinline__ float dpp_ror3(float v) { return __builtin_bit_cast(float, __builtin_amdgcn_update_dpp(0, __builtin_bit_cast(int, v), 0x123, 0xf, 0xf, false)); }
__device__ __forceinline__ f32x4 ror3v(f32x4 v) { return (f32x4){dpp_ror3(v[0]), dpp_ror3(v[1]), dpp_ror3(v[2]), dpp_ror3(v[3])}; }
template <int K> __device__ __forceinline__ float dpp_prev(float g, float gp) {
    const int o = __builtin_amdgcn_update_dpp(0, __builtin_bit_cast(int, gp), 0x120 + K, 0xf, 0xf, false);
    return __builtin_bit_cast(float, __builtin_amdgcn_update_dpp(o, __builtin_bit_cast(int, g), 0x110 + K, 0xf, 0xf, false));
}
template <int K> __device__ __forceinline__ f32x4 prevv(f32x4 g, f32x4 gp) { return (f32x4){dpp_prev<K>(g[0], gp[0]), dpp_prev<K>(g[1], gp[1]), dpp_prev<K>(g[2], gp[2]), dpp_prev<K>(g[3], gp[3])}; }
#ifndef EPI_WT
#define EPI_WT 0
#endif
template <int BIT> __device__ __forceinline__ void st16(void* p, u32x4 v) {
    if constexpr ((EPI_WT & BIT) != 0) asm volatile("global_store_dwordx4 %0, %1, off sc1\n\ts_nop 1" :: "v"(p), "v"(v) : "memory");
    else *(u32x4*)p = v;
}
__device__ __forceinline__ float dpp_shr1(float g, float old) { return __builtin_bit_cast(float, __builtin_amdgcn_update_dpp(__builtin_bit_cast(int, old), __builtin_bit_cast(int, g), 0x111, 0xf, 0xf, false)); }
__device__ __forceinline__ f32x4 shr1v(f32x4 g, f32x4 o) { return (f32x4){dpp_shr1(g[0], o[0]), dpp_shr1(g[1], o[1]), dpp_shr1(g[2], o[2]), dpp_shr1(g[3], o[3])}; }
__device__ __forceinline__ float silu_f(float v) { return v * __builtin_amdgcn_rcpf(1.0f + __builtin_amdgcn_exp2f(-1.44269504089f * v)); }
struct EpiProj {
    static constexpr bool PERM = true, APERM = true, AFTER_DRAIN = false, IDEMPOTENT = false, TWICE = true;
#ifdef PROBE_EPI_TWICE
    __device__ __forceinline__ bool twice(const Unit& u) const { return (PROBE_EPI_TWICE == 1) ? (u.pn < split_pn) : (PROBE_EPI_TWICE == 2) ? (u.pn >= split_pn) : (PROBE_EPI_TWICE == 5) ? (u.pn >= split_pn + 2) : false; }
#endif
    bf16_t* O0; int ld0; bf16_t* O1; int ld1; int split_pn; const ssq_t* sumsq; const float* zgain; const PG8_LAS float* sidef;
    const float* cw  ; float* qfirst; float* qlast  ; PG8_LAS f32x4* xl  ;
    int skip;
    __device__ __forceinline__ void side(const Unit& u, PG8_LAS unsigned char* lds, int par, int wid, int lane_in) const {
        int lane = lane_in; asm volatile("" : "+v"(lane));
        if (wid == 0 || wid == 7) __builtin_amdgcn_global_load_lds((const unsigned*)(sumsq + u.pm * BM + (wid ? 128 : 0) + 2 * lane), (PG8_LAS unsigned*)(lds + SIDE_OFF + par * SIDE_BYTES + SIDE_SSQ + (wid ? 1024 : 0)), 16, 0, 0);
        if (wid == 1) __builtin_amdgcn_global_load_lds((const unsigned*)(zgain + 4 * (lane & 31)), (PG8_LAS unsigned*)(lds + SIDE_OFF + par * SIDE_BYTES + 1024), 16, 0, 0);
        if (wid >= 2 && wid < 6 && u.pn < split_pn) __builtin_amdgcn_global_load_lds((const unsigned*)(cw + (wid - 2) * 1536 + u.pn * BM + 4 * lane), (PG8_LAS unsigned*)(lds + SIDE_OFF + par * SIDE_BYTES + 2048 + (wid - 2) * 1024), 16, 0, 0);
    }
    __device__ __forceinline__ void operator()(f32x4 (&acc)[2][2][4][2], const Unit& u, int wr, int wc, int fr, int fq, int par, bool unit_scale = false) const {
        if (skip) {
#pragma unroll
            for (int ai = 0; ai < 2; ++ai)
#pragma unroll
                for (int bj = 0; bj < 2; ++bj)
#pragma unroll
                    for (int m = 0; m < 4; ++m) asm volatile("" :: "v"(acc[ai][bj][m][0]), "v"(acc[ai][bj][m][1]));
            return; }
        const int rloc = wr * 64 + 4 * fr, row0 = u.pm * BM + rloc; const PG8_LAS float* sf = sidef + par * (SIDE_BYTES / 4);
#pragma unroll
        for (int ai = 0; ai < 2; ++ai) { const PG8_LAS ssq_t* sp = (const PG8_LAS ssq_t*)((const PG8_LAS unsigned char*)sf + SIDE_SSQ) + ai * HALF + rloc;
#pragma unroll
            for (int m = 0; m < 4; ++m) { float rs = __builtin_amdgcn_rsqf(ssq_val(sp[m]) * (1.0f / 1024.0f) + RMS_EPS); if (unit_scale) rs = 1.0f;
#pragma unroll
                for (int bj = 0; bj < 2; ++bj)
#pragma unroll
                    for (int n = 0; n < 2; ++n) acc[ai][bj][m][n] = acc[ai][bj][m][n] * rs; } }
        if (u.pn < split_pn) {
            const int wid = wr * 4 + wc, colt = u.pn * BM + wc * 32 + 8 * fq;
            if (fr == 15) {
#pragma unroll
                for (int ai = 0; ai < 2; ++ai) if (wr == 0 || ai == 0) {
#pragma unroll
                    for (int bj = 0; bj < 2; ++bj)
#pragma unroll
                        for (int n = 0; n < 2; ++n)
#pragma unroll
                            for (int jj = 0; jj < 3; ++jj) xl[wid * 96 + (((ai * 2 + bj) * 2 + n) * 4 + fq) * 3 + jj] = acc[ai][bj][jj + 1][n]; } }
            if (wr == 0 && fr == 0) {
#pragma unroll
                for (int bj = 0; bj < 2; ++bj)
#pragma unroll
                    for (int n = 0; n < 2; ++n)
#pragma unroll
                        for (int m = 0; m < 3; ++m) *(f32x4*)(qfirst + ((size_t)u.pm * 3 + m) * 1536 + colt + bj * HALF + 4 * n) = acc[0][bj][m][n]; }
            if (wr == 1 && fr == 15) {
#pragma unroll
                for (int bj = 0; bj < 2; ++bj)
#pragma unroll
                    for (int n = 0; n < 2; ++n)
#pragma unroll
                        for (int jj = 0; jj < 3; ++jj) *(f32x4*)(qlast + ((size_t)u.pm * 3 + jj) * 1536 + colt + bj * HALF + 4 * n) = acc[1][bj][jj + 1][n]; }
            asm volatile("s_waitcnt lgkmcnt(0)" ::: "memory"); __builtin_amdgcn_s_barrier(); asm volatile("" ::: "memory");
            const int swid = (wr == 1) ? wc : (4 + wc);
#pragma unroll
            for (int bj = 0; bj < 2; ++bj) { const int cl = bj * HALF + wc * 32 + 8 * fq;
                f32x4 w0[2], w1[2], w2[2], w3[2];
#pragma unroll
                for (int n = 0; n < 2; ++n) { w0[n] = *(const PG8_LAS f32x4*)(sf + 512 + cl + 4 * n); w1[n] = *(const PG8_LAS f32x4*)(sf + 768 + cl + 4 * n); w2[n] = *(const PG8_LAS f32x4*)(sf + 1024 + cl + 4 * n); w3[n] = *(const PG8_LAS f32x4*)(sf + 1280 + cl + 4 * n); }
#pragma unroll
                for (int ai = 0; ai < 2; ++ai) { const int sai = (wr == 1) ? ai : 0; u32x4 w[4];
#pragma unroll
                    for (int n = 0; n < 2; ++n) { f32x4 pv[3];
#pragma unroll
                        for (int jj = 0; jj < 3; ++jj) { pv[jj] = (f32x4){0.f, 0.f, 0.f, 0.f}; if (fr == 0 && (wr == 1 || ai == 1)) pv[jj] = xl[swid * 96 + (((sai * 2 + bj) * 2 + n) * 4 + fq) * 3 + jj]; }
                        const f32x4 g0 = acc[ai][bj][0][n], g1 = acc[ai][bj][1][n], g2 = acc[ai][bj][2][n], g3 = acc[ai][bj][3][n];
                        const f32x4 P1 = shr1v(g1, pv[0]), P2 = shr1v(g2, pv[1]), P3 = shr1v(g3, pv[2]);
                        f32x4 o[4];
                        o[0] = w0[n] * P1 + w1[n] * P2 + w2[n] * P3 + w3[n] * g0; o[1] = w0[n] * P2 + w1[n] * P3 + w2[n] * g0 + w3[n] * g1;
                        o[2] = w0[n] * P3 + w1[n] * g0 + w2[n] * g1 + w3[n] * g2; o[3] = w0[n] * g0 + w1[n] * g1 + w2[n] * g2 + w3[n] * g3;
#pragma unroll
                        for (int m = 0; m < 4; ++m) { const unsigned a = cvt_pk_bf16(silu_f(o[m][0]), silu_f(o[m][1])), b = cvt_pk_bf16(silu_f(o[m][2]), silu_f(o[m][3]));
                            if (n == 0) { w[m].x = a; w[m].y = b; } else { w[m].z = a; w[m].w = b; } } }
#pragma unroll
                    for (int m = 0; m < 4; ++m) st16<1>(O0 + (size_t)(row0 + ai * HALF + m) * ld0 + colt + bj * HALF, w[m]);
                } }
            return;
        }
        const int col0 = (u.pn - split_pn) * BM + wc * 32 + 8 * fq;
        const bool zt = (u.pn == split_pn) || (u.pn == split_pn + 1);
        f32x4 zg[2][2];
#pragma unroll
        for (int bj = 0; bj < 2; ++bj)
#pragma unroll
            for (int n = 0; n < 2; ++n) zg[bj][n] = *(const PG8_LAS f32x4*)(sf + 256 + ((col0 + bj * HALF + 4 * n) & 127));
#pragma unroll
        for (int ai = 0; ai < 2; ++ai)
#pragma unroll
            for (int m = 0; m < 4; ++m) { bf16_t* rowp = O1 + (size_t)(row0 + ai * HALF + m) * ld1 + col0;
#pragma unroll
                for (int bj = 0; bj < 2; ++bj) { f32x4 v0 = acc[ai][bj][m][0], v1 = acc[ai][bj][m][1];
                    if (zt) { v0 = (f32x4){silu_f(v0[0]), silu_f(v0[1]), silu_f(v0[2]), silu_f(v0[3])} * zg[bj][0]; v1 = (f32x4){silu_f(v1[0]), silu_f(v1[1]), silu_f(v1[2]), silu_f(v1[3])} * zg[bj][1]; }
                    u32x4 w; w.x = cvt_pk_bf16(v0[0], v0[1]); w.y = cvt_pk_bf16(v0[2], v0[3]); w.z = cvt_pk_bf16(v1[0], v1[1]); w.w = cvt_pk_bf16(v1[2], v1[3]);
                    st16<1>(rowp + bj * HALF, w); } }
    }
};
struct EpiNull {
    static constexpr bool PERM = true, APERM = false, AFTER_DRAIN = false, IDEMPOTENT = true, TWICE = false;
    __device__ __forceinline__ void side(const Unit&, PG8_LAS unsigned char*, int, int, int) const {}
    __device__ __forceinline__ void operator()(f32x4 (&acc)[2][2][4][2], const Unit&, int, int, int, int, int) const {
#pragma unroll
        for (int ai = 0; ai < 2; ++ai)
#pragma unroll
            for (int bj = 0; bj < 2; ++bj)
#pragma unroll
                for (int m = 0; m < 4; ++m) { asm volatile("" :: "v"(acc[ai][bj][m][0]), "v"(acc[ai][bj][m][1])); }
    }
};
struct EpiResid {
    static constexpr bool PERM = true, APERM = false, AFTER_DRAIN = false, IDEMPOTENT = false, TWICE = false;
    bf16_t* xb; ssq_t* sumsq;
    __device__ __forceinline__ void side(const Unit&, PG8_LAS unsigned char*, int, int, int) const {}
    __device__ __forceinline__ void operator()(f32x4 (&acc)[2][2][4][2], const Unit& u, int wr, int wc, int fr, int fq, int par) const {
        const int row0 = u.pm * BM + wr * 64 + fr, col0 = u.pn * BM + wc * 32 + 8 * fq;
#pragma unroll
        for (int ai = 0; ai < 2; ++ai) {
            u32x4 r[4][2];
#pragma unroll
            for (int m = 0; m < 4; ++m)
#pragma unroll
                for (int bj = 0; bj < 2; ++bj) r[m][bj] = *(const u32x4*)(xb + (size_t)(row0 + ai * HALF + m * 16) * 1024 + col0 + bj * HALF);
            asm volatile("" ::: "memory");
#pragma unroll
            for (int m = 0; m < 4; ++m) { const int row = row0 + ai * HALF + m * 16; float ss = 0.f;
#pragma unroll
                for (int bj = 0; bj < 2; ++bj) { const u32x4 q = r[m][bj];
                    const f32x4 o0 = (f32x4){__builtin_bit_cast(float, q.x << 16), __builtin_bit_cast(float, q.x & 0xffff0000u), __builtin_bit_cast(float, q.y << 16), __builtin_bit_cast(float, q.y & 0xffff0000u)} + acc[ai][bj][m][0];
                    const f32x4 o1 = (f32x4){__builtin_bit_cast(float, q.z << 16), __builtin_bit_cast(float, q.z & 0xffff0000u), __builtin_bit_cast(float, q.w << 16), __builtin_bit_cast(float, q.w & 0xffff0000u)} + acc[ai][bj][m][1];
                    ss += ((o0[0] * o0[0] + o0[1] * o0[1]) + (o0[2] * o0[2] + o0[3] * o0[3])) + ((o1[0] * o1[0] + o1[1] * o1[1]) + (o1[2] * o1[2] + o1[3] * o1[3]));
                    u32x4 w; w.x = cvt_pk_bf16(o0[0], o0[1]); w.y = cvt_pk_bf16(o0[2], o0[3]); w.z = cvt_pk_bf16(o1[0], o1[1]); w.w = cvt_pk_bf16(o1[2], o1[3]);
                    st16<4>(xb + (size_t)row * 1024 + col0 + bj * HALF, w); }
                ss += __shfl_xor(ss, 16); ss += __shfl_xor(ss, 32);
                if (fq == 0) atomicAdd(sumsq + row, ssq_pack(ss)); }
        }
    }
};
struct EpiGateUp {
    static constexpr bool PERM = true, APERM = true, AFTER_DRAIN = false, IDEMPOTENT = false, TWICE = true;
#ifdef PROBE_EPI_TWICE
    __device__ __forceinline__ bool twice(const Unit& u) const { return PROBE_EPI_TWICE == 3; }
#endif
    bf16_t* act; const ssq_t* sumsq; const float* cw  ; float* hfirst; float* ufirst; float* hlast; PG8_LAS f32x4* xl  ; const PG8_LAS float* sidef;
    __device__ __forceinline__ void side(const Unit& u, PG8_LAS unsigned char* lds, int par, int wid, int lane_in) const {
        int lane = lane_in; asm volatile("" : "+v"(lane));
        if (wid == 0 || wid == 7) __builtin_amdgcn_global_load_lds((const unsigned*)(sumsq + u.pm * BM + (wid ? 128 : 0) + 2 * lane), (PG8_LAS unsigned*)(lds + SIDE_OFF + par * SIDE_BYTES + SIDE_SSQ + (wid ? 1024 : 0)), 16, 0, 0);
        if (wid == 1) __builtin_amdgcn_global_load_lds((const unsigned*)(cw + (lane >> 5) * 2816 + u.pn * 128 + 4 * (lane & 31)), (PG8_LAS unsigned*)(lds + SIDE_OFF + par * SIDE_BYTES + 1024), 16, 0, 0);
        if (wid == 2) __builtin_amdgcn_global_load_lds((const unsigned*)(cw + 2 * 2816 + u.pn * 128 + 4 * (lane & 31)), (PG8_LAS unsigned*)(lds + SIDE_OFF + par * SIDE_BYTES + 2048), 16, 0, 0);
    }
    __device__ __forceinline__ void operator()(f32x4 (&acc)[2][2][4][2], const Unit& u, int wr, int wc, int fr, int fq, int par, bool unit_scale = false) const {
        const int rloc = wr * 64 + 4 * fr, row0 = u.pm * BM + rloc, colf = u.pn * 128 + wc * 32 + 8 * fq;
        const int wid = wr * 4 + wc; const PG8_LAS float* sf = sidef + par * (SIDE_BYTES / 4);
#pragma unroll
        for (int ai = 0; ai < 2; ++ai) { const PG8_LAS ssq_t* sp = (const PG8_LAS ssq_t*)((const PG8_LAS unsigned char*)sf + SIDE_SSQ) + ai * HALF + rloc;
#pragma unroll
            for (int m = 0; m < 4; ++m) { float rs = __builtin_amdgcn_rsqf(ssq_val(sp[m]) * (1.0f / 1024.0f) + RMS_EPS); if (unit_scale) rs = 1.0f;
#pragma unroll
                for (int bj = 0; bj < 2; ++bj)
#pragma unroll
                    for (int n = 0; n < 2; ++n) acc[ai][bj][m][n] = acc[ai][bj][m][n] * rs; } }
        if (fr == 15) {
#pragma unroll
            for (int ai = 0; ai < 2; ++ai) if (wr == 0 || ai == 0) {
#pragma unroll
                for (int n = 0; n < 2; ++n)
#pragma unroll
                    for (int jj = 0; jj < 2; ++jj) xl[wid * 64 + ((ai * 2 + n) * 4 + fq) * 2 + jj] = acc[ai][0][jj + 2][n]; }
        }
        if (wr == 0 && fr == 0) {
#pragma unroll
            for (int n = 0; n < 2; ++n)
#pragma unroll
                for (int m = 0; m < 2; ++m) { *(f32x4*)(hfirst + ((size_t)u.pm * 2 + m) * 2816 + colf + 4 * n) = acc[0][0][m][n]; *(f32x4*)(ufirst + ((size_t)u.pm * 2 + m) * 2816 + colf + 4 * n) = acc[0][1][m][n]; }
        }
        if (wr == 1 && fr == 15) {
#pragma unroll
            for (int n = 0; n < 2; ++n)
#pragma unroll
                for (int jj = 0; jj < 2; ++jj) *(f32x4*)(hlast + ((size_t)u.pm * 2 + jj) * 2816 + colf + 4 * n) = acc[1][0][jj + 2][n];
        }
        asm volatile("s_waitcnt lgkmcnt(0)" ::: "memory"); __builtin_amdgcn_s_barrier(); asm volatile("" ::: "memory");
        f32x4 w0[2], w1[2], w2[2];
#pragma unroll
        for (int n = 0; n < 2; ++n) { const int cl = wc * 32 + 8 * fq + 4 * n; w0[n] = *(const PG8_LAS f32x4*)(sf + 256 + cl); w1[n] = *(const PG8_LAS f32x4*)(sf + 384 + cl); w2[n] = *(const PG8_LAS f32x4*)(sf + 512 + cl); }
        const int swid = (wr == 1) ? wc : (4 + wc);
#pragma unroll
        for (int ai = 0; ai < 2; ++ai) { const int sai = (wr == 1) ? ai : 0; u32x4 w[4];
#pragma unroll
            for (int n = 0; n < 2; ++n) { f32x4 pv[2];
#pragma unroll
                for (int jj = 0; jj < 2; ++jj) { pv[jj] = (f32x4){0.f, 0.f, 0.f, 0.f}; if (fr == 0 && (wr == 1 || ai == 1)) pv[jj] = xl[swid * 64 + ((sai * 2 + n) * 4 + fq) * 2 + jj]; }
                const f32x4 g0 = acc[ai][0][0][n], g1 = acc[ai][0][1][n], g2 = acc[ai][0][2][n], g3 = acc[ai][0][3][n];
                const f32x4 P2 = shr1v(g2, pv[0]), P3 = shr1v(g3, pv[1]);
                f32x4 o[4];
                o[0] = w0[n] * P2 + w1[n] * P3 + w2[n] * g0; o[1] = w0[n] * P3 + w1[n] * g0 + w2[n] * g1; o[2] = w0[n] * g0 + w1[n] * g1 + w2[n] * g2; o[3] = w0[n] * g1 + w1[n] * g2 + w2[n] * g3;
#pragma unroll
                for (int m = 0; m < 4; ++m) { const f32x4 up = acc[ai][1][m][n];
                    const unsigned a = cvt_pk_bf16(silu_f(o[m][0]) * up[0], silu_f(o[m][1]) * up[1]), b = cvt_pk_bf16(silu_f(o[m][2]) * up[2], silu_f(o[m][3]) * up[3]);
                    if (n == 0) { w[m].x = a; w[m].y = b; } else { w[m].z = a; w[m].w = b; } } }
#pragma unroll
            for (int m = 0; m < 4; ++m) st16<2>(act + (size_t)(row0 + ai * HALF + m) * 2816 + colf, w[m]);
        }
    }
};

template <class Epi, class Sched, bool ALIGN_EPI = false, bool SP2 = false>
__device__ __forceinline__ void gemm_phase(PG8_LAS unsigned char* lds, const Gemm g, const Sched& S, const Epi& E, int tid_in) {
    int tid_o = tid_in; asm volatile("" : "+v"(tid_o));
    const int tid = tid_o, wid = __builtin_amdgcn_readfirstlane(tid >> 6), lane = tid & 63, wr = wid >> 2, wc = wid & 3, fr = lane & 15, fq = lane >> 4;
    const int K = g.K, nt = K / BK;
    unsigned voffA[2], voffB[2];
#pragma unroll
    for (int i = 0; i < 2; ++i) { int R, C; stage_rc(tid * 16 + i * 8192, R, C); const int Rb = Epi::PERM ? ((R & ~31) + perm32(R & 31)) : R;
        const int Ra = Epi::APERM ? ((R & ~63) + 4 * (R & 15) + ((R >> 4) & 3)) : R;
        voffA[i] = (unsigned)(Ra * K + C) * 2u; voffB[i] = (unsigned)(Rb * K + C) * 2u; }
    const size_t kstep = (size_t)(BK * 2);
    const size_t hstep = (size_t)HALF * K * 2;
    const size_t tstep = 2 * hstep;
    const unsigned ldsw = (unsigned)wid * 1024u;
    const int aoff = lds_byte(wr * 64 + fr, fq * 8), boff = lds_byte(wc * 32 + fr, fq * 8);
#define PG8_SA(b, h) (((b) * 2 + (h)) * HTB)
#define PG8_SB(b, h) ((4 + (b) * 2 + (h)) * HTB)
#define PG8_STAGE(bufoff, gbase, voff) do { _Pragma("unroll") for (int _i = 0; _i < 2; ++_i) \
        __builtin_amdgcn_global_load_lds((const unsigned*)((const char*)(gbase) + (voff)[_i]), (PG8_LAS unsigned*)(lds + (bufoff) + ldsw + _i * 8192), 16, 0, 0); } while (0)
#define PG8_LDA(dst, b, h) do { _Pragma("unroll") for (int m = 0; m < 4; ++m) _Pragma("unroll") for (int k = 0; k < 2; ++k) dst[m][k] = *(const PG8_LAS bf16x8*)(lds + PG8_SA(b, h) + aoff + m * 2048 + k * 1024); } while (0)
#define PG8_LDB(dst, b, h) do { _Pragma("unroll") for (int n = 0; n < 2; ++n) _Pragma("unroll") for (int k = 0; k < 2; ++k) dst[n][k] = *(const PG8_LAS bf16x8*)(lds + PG8_SB(b, h) + boff + n * 2048 + k * 1024); } while (0)
#define PG8_MMA(ai, bj, At, Bt) do { __builtin_amdgcn_s_setprio(1); _Pragma("unroll") for (int m = 0; m < 4; ++m) _Pragma("unroll") for (int n = 0; n < 2; ++n) _Pragma("unroll") for (int k = 0; k < 2; ++k) \
        acc[ai][bj][m][n] = __builtin_amdgcn_mfma_f32_16x16x32_bf16(Bt[n][k], At[m][k], acc[ai][bj][m][n], 0, 0, 0); __builtin_amdgcn_s_setprio(0); } while (0)
#define PG8_WAIT_V(n) asm volatile("s_waitcnt vmcnt(" #n ")" ::: "memory")
#define PG8_WAIT_L(n) asm volatile("s_waitcnt lgkmcnt(" #n ")" ::: "memory")
#define PG8_BAR __builtin_amdgcn_s_barrier()
#define PG8_SCHED __builtin_amdgcn_sched_barrier(0)
    Unit cur, nxt; int ui = 0;
    if (!S.next(0, cur)) return;
    f32x4 acc[2][2][4][2];
#pragma unroll
    for (int a = 0; a < 2; ++a)
#pragma unroll
        for (int b = 0; b < 2; ++b)
#pragma unroll
            for (int m = 0; m < 4; ++m)
#pragma unroll
                for (int n = 0; n < 2; ++n) acc[a][b][m][n] = (f32x4){0.f, 0.f, 0.f, 0.f};
    bf16x8 At[4][2], B0[2][2], B1[2][2];
    const char* cA = (const char*)g.A + (size_t)cur.pm * tstep; const char* cB = (const char*)g.Bt + (size_t)cur.pn * tstep;
    S.a_ready(cur);
    E.side(cur, lds, 0, wid, lane);
    if constexpr (SP2) {
        PG8_STAGE(PG8_SB(0, 0), cB, voffB); PG8_STAGE(PG8_SB(0, 1), cB + hstep, voffB); PG8_STAGE(PG8_SA(0, 0), cA, voffA); PG8_STAGE(PG8_SA(0, 1), cA + hstep, voffA);
        if (wr == 1) PG8_BAR;
        PG8_WAIT_V(2); PG8_BAR;
        PG8_STAGE(PG8_SB(1, 0), cB + kstep, voffB); PG8_STAGE(PG8_SA(1, 0), cA + kstep, voffA); PG8_STAGE(PG8_SB(1, 1), cB + hstep + kstep, voffB);
        PG8_WAIT_V(6); PG8_BAR;
    } else {
        PG8_STAGE(PG8_SB(0, 0), cB, voffB); PG8_STAGE(PG8_SA(0, 0), cA, voffA); PG8_STAGE(PG8_SB(0, 1), cB + hstep, voffB); PG8_STAGE(PG8_SA(0, 1), cA + hstep, voffA);
        if (wr == 1) PG8_BAR;
        PG8_WAIT_V(4); PG8_BAR;
        PG8_STAGE(PG8_SB(1, 0), cB + kstep, voffB); PG8_STAGE(PG8_SA(1, 0), cA + kstep, voffA); PG8_STAGE(PG8_SB(1, 1), cB + hstep + kstep, voffB);
        PG8_WAIT_V(6); PG8_BAR;
    }
    for (;;) {
        const bool has_next = S.next(ui + 1, nxt);
        const char* nA = has_next ? (const char*)g.A + (size_t)nxt.pm * tstep : cA; const char* nB = has_next ? (const char*)g.Bt + (size_t)nxt.pn * tstep : cB;
        for (int t = 0; t < nt; t += 2) {
            const bool last = (t == nt - 2);
            const char* a1 = cA + (size_t)(t + 1) * kstep;
            const char* a2 = last ? nA : cA + (size_t)(t + 2) * kstep; const char* b2 = last ? nB : cB + (size_t)(t + 2) * kstep;
            const char* a3 = a2 + kstep; const char* b3 = b2 + kstep;
            if (last && has_next) S.a_ready(nxt);
            if constexpr (SP2) {
            PG8_LDB(B0, 0, 0); PG8_LDB(B1, 0, 1); PG8_SCHED; PG8_LDA(At, 0, 0); PG8_STAGE(PG8_SA(1, 1), a1 + hstep, voffA);
            PG8_WAIT_V(8); PG8_WAIT_L(0); PG8_BAR; PG8_MMA(0, 0, At, B0); PG8_MMA(0, 1, At, B1); PG8_BAR; PG8_SCHED;
            PG8_LDA(At, 0, 1); PG8_STAGE(PG8_SB(0, 0), b2, voffB); PG8_STAGE(PG8_SB(0, 1), b2 + hstep, voffB); PG8_STAGE(PG8_SA(0, 0), a2, voffA);
            PG8_WAIT_V(8); PG8_WAIT_L(0); PG8_BAR; PG8_MMA(1, 0, At, B0); PG8_MMA(1, 1, At, B1); PG8_BAR; PG8_SCHED;
            PG8_LDB(B0, 1, 0); PG8_LDB(B1, 1, 1); PG8_SCHED; PG8_LDA(At, 1, 0); PG8_STAGE(PG8_SA(0, 1), a2 + hstep, voffA);
            PG8_WAIT_V(8); PG8_WAIT_L(0); PG8_BAR; PG8_MMA(0, 0, At, B0); PG8_MMA(0, 1, At, B1); PG8_BAR; PG8_SCHED;
            PG8_LDA(At, 1, 1); PG8_STAGE(PG8_SB(1, 0), b3, voffB); PG8_STAGE(PG8_SB(1, 1), b3 + hstep, voffB); PG8_STAGE(PG8_SA(1, 0), a3, voffA);
            PG8_WAIT_V(8); PG8_WAIT_L(0); PG8_BAR; PG8_MMA(1, 0, At, B0); PG8_MMA(1, 1, At, B1); PG8_BAR; PG8_SCHED;
            } else {
            PG8_LDB(B0, 0, 0); PG8_SCHED; PG8_LDA(At, 0, 0); PG8_STAGE(PG8_SA(1, 1), a1 + hstep, voffA);
            PG8_WAIT_L(8); PG8_BAR; PG8_WAIT_L(0); PG8_MMA(0, 0, At, B0); PG8_BAR; PG8_SCHED;
            PG8_LDB(B1, 0, 1); PG8_STAGE(PG8_SB(0, 0), b2, voffB);
            PG8_BAR; PG8_WAIT_L(0); PG8_MMA(0, 1, At, B1); PG8_BAR;
            PG8_LDA(At, 0, 1); PG8_STAGE(PG8_SA(0, 0), a2, voffA);
            PG8_BAR; PG8_WAIT_L(0); PG8_MMA(1, 0, At, B0); PG8_BAR; PG8_SCHED;
            PG8_STAGE(PG8_SB(0, 1), b2 + hstep, voffB);
            PG8_WAIT_V(6); PG8_BAR; PG8_MMA(1, 1, At, B1); PG8_BAR;
            PG8_LDB(B0, 1, 0); PG8_SCHED; PG8_LDA(At, 1, 0); PG8_STAGE(PG8_SA(0, 1), a2 + hstep, voffA);
            PG8_WAIT_L(8); PG8_BAR; PG8_WAIT_L(0); PG8_MMA(0, 0, At, B0); PG8_BAR; PG8_SCHED;
            PG8_LDB(B1, 1, 1); PG8_STAGE(PG8_SB(1, 0), b3, voffB);
            PG8_BAR; PG8_WAIT_L(0); PG8_MMA(0, 1, At, B1); PG8_BAR;
            PG8_LDA(At, 1, 1); PG8_STAGE(PG8_SA(1, 0), a3, voffA);
            PG8_BAR; PG8_WAIT_L(0); PG8_MMA(1, 0, At, B0); PG8_BAR; PG8_SCHED;
            PG8_STAGE(PG8_SB(1, 1), b3 + hstep, voffB);
            PG8_WAIT_V(6); PG8_BAR; PG8_MMA(1, 1, At, B1); PG8_BAR;
            }
        }
        if constexpr (ALIGN_EPI) { if (wr == 0) PG8_BAR; }
        if constexpr (!Epi::AFTER_DRAIN) { E(acc, cur, wr, wc, fr, fq, ui & 1);
#ifdef PROBE_EPI_TWICE
            if constexpr (Epi::TWICE) { if (E.twice(cur)) E(acc, cur, wr, wc, fr, fq, ui & 1, true); }
#endif
            S.done(cur); }
        if (!has_next) break;
#pragma unroll
        for (int a = 0; a < 2; ++a)
#pragma unroll
            for (int b = 0; b < 2; ++b)
#pragma unroll
                for (int m = 0; m < 4; ++m)
#pragma unroll
                    for (int n = 0; n < 2; ++n) acc[a][b][m][n] = (f32x4){0.f, 0.f, 0.f, 0.f};
        cur = nxt; cA = nA; cB = nB; ++ui;
        E.side(cur, lds, ui & 1, wid, lane);
        if constexpr (ALIGN_EPI) { if (wr == 1) PG8_BAR; }
    }
    PG8_WAIT_V(0);
    if constexpr (!ALIGN_EPI) { if (wr == 0) PG8_BAR; }
    PG8_BAR;
    if constexpr (Epi::AFTER_DRAIN) { E.fused(acc, cur, wr, wc, fr, fq, lds, wid, lane); S.done(cur); }
#undef PG8_SA
#undef PG8_SB
#undef PG8_STAGE
#undef PG8_LDA
#undef PG8_LDB
#undef PG8_MMA
#undef PG8_WAIT_V
#undef PG8_WAIT_L
#undef PG8_BAR
#undef PG8_SCHED
}
}
#ifndef PG8_SP2
#define PG8_SP2 true
#endif
#ifndef MK_SPLIT
#define MK_SPLIT 0
#endif

constexpr int NWAVES = 8, NTHREADS = 512;
constexpr int DM = 1024, SEQ = 4096, NB = 8, T = NB * SEQ, INC = 3592, NIN = 3584, DFF = 2816, NGU = 2 * DFF, DEPTH = 2;
constexpr int NPHASE = 2 + 6 * DEPTH;
constexpr size_t MiB = 1u << 20;
constexpr size_t WS_CTL = 0, CTL_ZERO_BYTES = 2 * MiB;
constexpr size_t WS_SUMSQ = 512 * 1024;
static_assert(WS_SUMSQ + 5 * (size_t)T * 8 <= CTL_ZERO_BYTES, "sumsq inside the zeroed region");
constexpr size_t WS_WLOG = 2 * MiB;
constexpr size_t WS_BG = 3 * MiB;
constexpr size_t WS_HFIRST = 4 * MiB, WS_UFIRST = 7 * MiB, WS_HLAST = 10 * MiB;
constexpr size_t WS_WIN = 16 * MiB, WS_WOUT = 30 * MiB, WS_WGU = 34 * MiB, WS_WD = 56 * MiB;
constexpr size_t WS_XB = 68 * MiB;
constexpr size_t WS_PA = 132 * MiB;
constexpr size_t WS_PREST = 228 * MiB;
constexpr size_t WS_ACT = 132 * MiB;
constexpr size_t WS_REC1 = 356 * MiB;
constexpr size_t WS_REC0 = 437 * MiB;
#define Y_BASE(F) ((unsigned char*)(F).out)
constexpr size_t WS_QFIRST = 501 * MiB, WS_QLAST = 504 * MiB;
constexpr size_t WS_END = 507 * MiB;
constexpr int REC_BYTES_C = 73728, REC0_N = 910;
static_assert((size_t)REC0_N * REC_BYTES_C <= 64 * MiB && (size_t)(2048 - REC0_N) * REC_BYTES_C <= 81 * MiB, "record regions");
constexpr int CW_BAR = 4096;
constexpr int RING_OFF = 0, RING_BYTES = 131072;
constexpr int XL_OFF = RING_BYTES;
constexpr int LDS_BYTES = 163840;
constexpr int LDSCTL_OFF = LDS_BYTES - 1024, MISC_OFF = LDSCTL_OFF + 320;

#define GAS __attribute__((address_space(1)))
#define LAS __attribute__((address_space(3)))
typedef unsigned short bf16;
typedef unsigned v4u __attribute__((ext_vector_type(4)));
typedef unsigned v2u __attribute__((ext_vector_type(2)));
typedef float f32x4 __attribute__((ext_vector_type(4)));
typedef short bf16x8 __attribute__((ext_vector_type(8)));
#define LDS_WAIT() asm volatile("s_waitcnt lgkmcnt(0)" ::: "memory")
#define VM_WAIT() asm volatile("s_waitcnt vmcnt(0)" ::: "memory")
__device__ __forceinline__ unsigned f2bf(float f) { unsigned u = __builtin_bit_cast(unsigned, f); return (u + 0x7fffu + ((u >> 16) & 1u)) >> 16; }
__device__ __forceinline__ unsigned pk2(float lo, float hi) { return f2bf(lo) | (f2bf(hi) << 16); }
__device__ __forceinline__ float bf2f(bf16 b) { return __builtin_bit_cast(float, ((unsigned)b) << 16); }
__device__ __forceinline__ float bflo(unsigned w) { return __builtin_bit_cast(float, w << 16); }
__device__ __forceinline__ float bfhi(unsigned w) { return __builtin_bit_cast(float, w & 0xffff0000u); }

#define XB_TMO      128
#define XB_XCNT(j)  (256  + 64 * (j))
#define XB_XSUB(j)  (1280 + 64 * (j))
#define XB_XGEN(j)  (2304 + 64 * (j))
#define XB_TOP      3328
#define XB_TOPGEN   3392
#define XCD_BAR_WORDS 3456
#define XB_SPIN_CAP (1u << 22)
__device__ __forceinline__ unsigned xb_ld(unsigned* p)              { return __hip_atomic_load(p, __ATOMIC_RELAXED, __HIP_MEMORY_SCOPE_AGENT); }
__device__ __forceinline__ unsigned xb_add(unsigned* p, unsigned v) { return __hip_atomic_fetch_add(p, v, __ATOMIC_RELAXED, __HIP_MEMORY_SCOPE_AGENT); }
__device__ __forceinline__ unsigned xb_xcc_id() { return (unsigned)__builtin_amdgcn_s_getreg((3 << 11) | 20) & 0xFu; }
#define XB_SPIN(cond, bar) do { unsigned _sp = 0; while (cond) { __builtin_amdgcn_s_sleep(1); \
    if ((++_sp & 255u) == 0u) { if (xb_ld(&(bar)[XB_TMO])) break; if (_sp > XB_SPIN_CAP) { atomicAdd(&(bar)[XB_TMO], 1u); break; } } } } while (0)
struct XcdBarrier { unsigned* bar; unsigned x; volatile LAS unsigned* st; };
__device__ __forceinline__ XcdBarrier xcd_barrier_post(unsigned* bar, volatile LAS unsigned* st) {
    XcdBarrier b; b.bar = bar; b.x = xb_xcc_id(); b.st = st;
    if (threadIdx.x == 0) (void)xb_add(&bar[XB_XCNT(b.x)], 1u);
    return b;
}
__device__ __forceinline__ void xcd_barrier_complete(unsigned* bar, unsigned x, unsigned& nloc, unsigned& nx) {
    const unsigned G = gridDim.x * gridDim.y * gridDim.z;
    unsigned sum, cnt, mine, sp = 0u;
    for (;;) {
        sum = 0u; cnt = 0u; mine = 0u;
#pragma unroll
        for (unsigned j = 0; j < 16; ++j) { const unsigned c = xb_ld(&bar[XB_XCNT(j)]); sum += c; cnt += (c > 0u) ? 1u : 0u; mine = (j == x) ? c : mine; }
        if (sum == G) break;
        __builtin_amdgcn_s_sleep(1);
        if ((++sp & 255u) == 0u) { if (xb_ld(&bar[XB_TMO])) break; if (sp > XB_SPIN_CAP) { atomicAdd(&bar[XB_TMO], 1u); break; } }
    }
    nloc = mine > 0u ? mine : 1u; nx = cnt > 0u ? cnt : 1u;
}
__device__ __forceinline__ void xcd_census(const XcdBarrier& b) {
    if (b.st[0] == 0u && threadIdx.x < 64u) {
        const unsigned ln = threadIdx.x, G = gridDim.x * gridDim.y * gridDim.z; unsigned c = 0u, sum = 0u;
        for (unsigned sp = 0; sp < XB_SPIN_CAP; ++sp) {
            c = (ln < 16u) ? xb_ld(&b.bar[XB_XCNT(ln)]) : 0u; sum = c;
#pragma unroll
            for (int o = 1; o < 16; o <<= 1) sum += __shfl_xor(sum, o);
            sum = __shfl(sum, 0);
            if (sum == G) break;
            __builtin_amdgcn_s_sleep(1);
            if ((sp & 255u) == 255u && xb_ld(&b.bar[XB_TMO])) break;
        }
        if (sum != G && ln == 0u) atomicAdd(&b.bar[XB_TMO], 1u);
        const unsigned long long nz = __ballot(c > 0u); const unsigned mine = __shfl(c, (int)b.x);
        if (ln == 0u) { b.st[0] = mine > 0u ? mine : 1u; b.st[1] = nz ? (unsigned)__popcll(nz) : 1u; }
        asm volatile("s_waitcnt lgkmcnt(0)" ::: "memory");
    }
}
__device__ __forceinline__ void xcd_barrier(const XcdBarrier& b) {
    asm volatile("s_waitcnt vmcnt(0)" ::: "memory");
    __syncthreads();
    if (threadIdx.x == 0) {
        unsigned* bar = b.bar;
        __builtin_amdgcn_s_waitcnt(0);
        unsigned nloc = b.st[0], nx = b.st[1];
        if (nloc == 0u) { xcd_barrier_complete(bar, b.x, nloc, nx); b.st[0] = nloc; b.st[1] = nx; }
        const unsigned old = xb_add(&bar[XB_XSUB(b.x)], 1u);
        const unsigned gen = old / nloc;
        if (old + 1u == (gen + 1u) * nloc) {
            __builtin_amdgcn_fence(__ATOMIC_RELEASE, "agent");
            asm volatile("s_waitcnt vmcnt(0)" ::: "memory");
            const unsigned og = xb_add(&bar[XB_TOP], 1u);
            const unsigned tg = og / nx;
            if (og + 1u == (tg + 1u) * nx) xb_add(&bar[XB_TOPGEN], 1u);
            else XB_SPIN(xb_ld(&bar[XB_TOPGEN]) == tg, bar);
            __builtin_amdgcn_fence(__ATOMIC_ACQUIRE, "agent");
            xb_add(&bar[XB_XGEN(b.x)], 1u);
            asm volatile("s_waitcnt vmcnt(0)" ::: "memory");
        } else {
            XB_SPIN(xb_ld(&bar[XB_XGEN(b.x)]) == gen, bar);
            __builtin_amdgcn_fence(__ATOMIC_ACQUIRE, "agent");
            asm volatile("s_waitcnt vmcnt(0)" ::: "memory");
        }
    }
    __syncthreads();
}

struct Args { const float* in[14]; float* out; unsigned char* ws; int ph_lo, ph_hi; };
struct Frame {
    LAS unsigned char* lds;
    int tid, lane, wave, G, bid;
    const float *x, *ln1, *w_in, *conv_qkv, *a_log, *dt_bias, *gdn_norm, *w_out, *ln2, *w_gate, *w_up, *ffn_conv, *w_down, *ln_f;
    float* out; unsigned char* ws;
};
__device__ __forceinline__ float wave_sum(float v) {
#pragma unroll
    for (int o = 1; o < 64; o <<= 1) v += __shfl_xor(v, o);
    return v;
}
__device__ __forceinline__ float silu_acc(float v) { return v / (1.0f + __expf(-v)); }

template <bool GAIN>
__device__ __forceinline__ void p0_transpose_item(const float* W, int ldw, int c0, int k0, int K, bf16* WT, int r0, const float* gain, LAS float* scr, int lane) {
    f32x4 v[8]; float gv[8];
#pragma unroll
    for (int i = 0; i < 8; ++i) { const int kk = 8 * i + (lane >> 3); v[i] = *(const f32x4*)(W + (size_t)(k0 + kk) * ldw + c0 + 4 * (lane & 7)); gv[i] = GAIN ? gain[k0 + kk] : 1.f; }
#pragma unroll
    for (int i = 0; i < 8; ++i) { const int kk = 8 * i + (lane >> 3), cc = 4 * (lane & 7); const f32x4 x = GAIN ? v[i] * gv[i] : v[i];
        scr[kk * 33 + cc] = x.x; scr[kk * 33 + cc + 1] = x.y; scr[kk * 33 + cc + 2] = x.z; scr[kk * 33 + cc + 3] = x.w; }
    LDS_WAIT(); asm volatile("" ::: "memory");
    const int c = lane & 7;
#pragma unroll
    for (int j = 0; j < 4; ++j) { const int n = (lane >> 3) + 8 * j; const LAS float* s = scr + (8 * c) * 33 + n;
        v4u o; o.x = pk2(s[0 * 33], s[1 * 33]); o.y = pk2(s[2 * 33], s[3 * 33]); o.z = pk2(s[4 * 33], s[5 * 33]); o.w = pk2(s[6 * 33], s[7 * 33]);
        *(v4u*)(WT + (size_t)(r0 + n) * K + k0 + 8 * c) = o; }
    LDS_WAIT(); asm volatile("" ::: "memory");
}
__device__ __forceinline__ void phase_p0(Frame& F) {
    LAS float* scr = (LAS float*)(F.lds + RING_OFF + F.wave * 16384);
    const int gw = F.bid * NWAVES + F.wave, NGW = F.G * NWAVES;
    constexpr int KB = DM / 64, KBD = DFF / 64;
    constexpr int I_IN = KB * (NIN / 32), I_OUT = KB * (DM / 32), I_GU = KB * (NGU / 32), I_D = KBD * (DM / 32), I_L = I_IN + I_OUT + I_GU + I_D;
    for (int it = gw; it < DEPTH * I_L; it += NGW) {
        const int l = it / I_L; int r = it % I_L;
        if (r < I_IN) { const int kb = r / (NIN / 32), nb = r % (NIN / 32), r0 = 32 * nb, c0 = r0 + (r0 >= 2048 ? 8 : 0);
            p0_transpose_item<true>(F.w_in + (size_t)l * DM * INC, INC, c0, 64 * kb, DM, (bf16*)(F.ws + WS_WIN) + (size_t)l * NIN * DM, r0, F.ln1 + l * DM, scr, F.lane); continue; } r -= I_IN;
        if (r < I_OUT) { const int kb = r / (DM / 32), nb = r % (DM / 32);
            p0_transpose_item<false>(F.w_out + (size_t)l * DM * DM, DM, 32 * nb, 64 * kb, DM, (bf16*)(F.ws + WS_WOUT) + (size_t)l * DM * DM, 32 * nb, nullptr, scr, F.lane); continue; } r -= I_OUT;
        if (r < I_GU) { const int kb = r / (NGU / 32), nb = r % (NGU / 32), r0 = 32 * nb, pn = r0 >> 8, rr = r0 & 255;
            const float* W = (rr < 128) ? F.w_gate : F.w_up; const int c0 = 128 * pn + (rr & 127);
            p0_transpose_item<true>(W + (size_t)l * DM * DFF, DFF, c0, 64 * kb, DM, (bf16*)(F.ws + WS_WGU) + (size_t)l * NGU * DM, r0, F.ln2 + l * DM, scr, F.lane); continue; } r -= I_GU;
        { const int kb = r / (DM / 32), nb = r % (DM / 32);
            p0_transpose_item<false>(F.w_down + (size_t)l * DFF * DM, DM, 32 * nb, 64 * kb, DFF, (bf16*)(F.ws + WS_WD) + (size_t)l * DM * DFF, 32 * nb, nullptr, scr, F.lane); }
    }
    for (int i = F.bid * NTHREADS + F.tid; i < DEPTH * 8 * DM; i += F.G * NTHREADS) { const int l = i / (8 * DM), j = (i / DM) % 8, k = i % DM;
        ((bf16*)(F.ws + WS_WLOG))[i] = (bf16)f2bf(F.w_in[(size_t)l * DM * INC + (size_t)k * INC + 2048 + j] * F.ln1[l * DM + k]); }
    pg8::ssq_t* ss0 = (pg8::ssq_t*)(F.ws + WS_SUMSQ);
    for (int m0 = gw * 4; m0 < T; m0 += NGW * 4) {
        f32x4 v[4][4];
#pragma unroll
        for (int r = 0; r < 4; ++r) { const f32x4* xr = (const f32x4*)(F.x + (size_t)(m0 + r) * DM) + F.lane;
#pragma unroll
            for (int j = 0; j < 4; ++j) v[r][j] = xr[64 * j]; }
#pragma unroll
        for (int r = 0; r < 4; ++r) { float s = 0.f;
#pragma unroll
            for (int j = 0; j < 4; ++j) s += (v[r][j].x * v[r][j].x + v[r][j].y * v[r][j].y) + (v[r][j].z * v[r][j].z + v[r][j].w * v[r][j].w);
            s = wave_sum(s);
            unsigned long long* o8 = (unsigned long long*)((bf16*)(F.ws + WS_XB) + (size_t)(m0 + r) * DM) + F.lane;
#pragma unroll
            for (int j = 0; j < 4; ++j) o8[64 * j] = (unsigned long long)pk2(v[r][j].x, v[r][j].y) | ((unsigned long long)pk2(v[r][j].z, v[r][j].w) << 32);
            if (F.lane == 0) ss0[m0 + r] = pg8::ssq_pack(s); }
    }
}
constexpr int R_AQ = 32768, R_KT = 40960, R_U = 57344, REC_BYTES = REC_BYTES_C, REC_LDS = 57344, QTR = 14336;
__device__ __forceinline__ constexpr int R_WNF(int f) { return 2048 * f; }
__device__ __forceinline__ constexpr int R_QDF(int f) { return 2048 * f + 1024; }
__device__ __forceinline__ unsigned char* rec_ptr(const Frame& F, int r) { return r < REC0_N ? F.ws + WS_REC0 + (size_t)r * REC_BYTES : F.ws + WS_REC1 + (size_t)(r - REC0_N) * REC_BYTES; }
constexpr int R_DL = R_AQ + 2048;
constexpr int PI_ST = 272, P_QB = 0, P_KB = 17408, P_RV = 34816, P_RK = 52224, P_AM = 69632, P_TT = 87040, P_TC = 104448, P_XT = 121856, P_YT = 124416, P_LG = 129024, P_GC = 131072, P_LP = 139264;
__device__ __forceinline__ int kperm(int s, int hh, int jj) { return 16 * s + 8 * (jj >> 2) + 4 * hh + (jj & 3); }
__device__ __forceinline__ float dpp_xor1(float v) { return __builtin_bit_cast(float, __builtin_amdgcn_update_dpp(0, __builtin_bit_cast(int, v), 0xB1, 0xf, 0xf, false)); }
typedef float f32x16 __attribute__((ext_vector_type(16)));
typedef short s16x4 __attribute__((ext_vector_type(4)));
#define MFMA32(a, b, c) __builtin_amdgcn_mfma_f32_32x32x16_bf16((a), (b), (c), 0, 0, 0)
__device__ __forceinline__ bf16x8 pack8(const f32x16& x, int s) {
    v4u o; o.x = pg8::cvt_pk_bf16(x[8 * s + 0], x[8 * s + 1]); o.y = pg8::cvt_pk_bf16(x[8 * s + 2], x[8 * s + 3]); o.z = pg8::cvt_pk_bf16(x[8 * s + 4], x[8 * s + 5]); o.w = pg8::cvt_pk_bf16(x[8 * s + 6], x[8 * s + 7]);
    return __builtin_bit_cast(bf16x8, o);
}
__device__ __forceinline__ bf16x8 cvt8(const f32x4 a, const f32x4 b) {
    v4u o; o.x = pg8::cvt_pk_bf16(a[0], a[1]); o.y = pg8::cvt_pk_bf16(a[2], a[3]); o.z = pg8::cvt_pk_bf16(b[0], b[1]); o.w = pg8::cvt_pk_bf16(b[2], b[3]); return __builtin_bit_cast(bf16x8, o);
}
__device__ __forceinline__ bf16x8 tr_frag(const LAS unsigned char* img, int r0, int rstep, int c0, int lane) {
    const LAS unsigned char* p = img + (r0 + ((lane & 15) >> 2)) * PI_ST + (c0 + 16 * ((lane >> 4) & 1) + 4 * (lane & 3)) * 2;
    const s16x4 lo = __builtin_amdgcn_ds_read_tr16_b64_v4i16((LAS s16x4*)p), hi = __builtin_amdgcn_ds_read_tr16_b64_v4i16((LAS s16x4*)(p + rstep * PI_ST));
    return (bf16x8){lo[0], lo[1], lo[2], lo[3], hi[0], hi[1], hi[2], hi[3]};
}
#ifndef DUP_RECORDS
#define DUP_RECORDS 0
#endif
__device__ __forceinline__ void st_wt16_raw(void* p, v4u v) { asm volatile("global_store_dwordx4 %0, %1, off sc1\n\ts_nop 1" :: "v"(p), "v"(v) : "memory"); }
__device__ __forceinline__ void st_wt16x(void* p, v4u v, long long dup) { st_wt16_raw(p, v); if (DUP_RECORDS && dup) st_wt16_raw((char*)p + dup, v); }
#define st_wt16(p, v) st_wt16x((p), (v), dupd)
__device__ __forceinline__ float wave_sum_dpp(float v) {
    v += __builtin_bit_cast(float, __builtin_amdgcn_update_dpp(0, __builtin_bit_cast(int, v), 0x111, 0xf, 0xf, true));
    v += __builtin_bit_cast(float, __builtin_amdgcn_update_dpp(0, __builtin_bit_cast(int, v), 0x112, 0xf, 0xf, true));
    v += __builtin_bit_cast(float, __builtin_amdgcn_update_dpp(0, __builtin_bit_cast(int, v), 0x114, 0xf, 0xf, true));
    v += __builtin_bit_cast(float, __builtin_amdgcn_update_dpp(0, __builtin_bit_cast(int, v), 0x118, 0xf, 0xf, true));
    v += __builtin_bit_cast(float, __builtin_amdgcn_update_dpp(0, __builtin_bit_cast(int, v), 0x142, 0xa, 0xf, false));
    v += __builtin_bit_cast(float, __builtin_amdgcn_update_dpp(0, __builtin_bit_cast(int, v), 0x143, 0xc, 0xf, false));
    return __builtin_bit_cast(float, __builtin_amdgcn_readlane(__builtin_bit_cast(int, v), 63));
}
__device__ __forceinline__ void logits_phase(Frame& F, int l, const pg8::ssq_t* sumsq) {
    LAS unsigned char* L = F.lds; LAS float* LP = (LAS float*)(L + P_LP);
    const bf16* xb = (const bf16*)(F.ws + WS_XB); const bf16* wlb = (const bf16*)(F.ws + WS_WLOG) + (size_t)l * 8 * DM; float* bg = (float*)(F.ws + WS_BG);
    const int lane = F.lane, wave = F.wave, tid = F.tid, hh = lane >> 5, c31 = lane & 31; const float L2E = 1.44269504089f;
    for (int t0 = F.bid * 64; t0 < T; t0 += F.G * 64) {
        {
            f32x16 C0, C1;
#pragma unroll
            for (int r = 0; r < 16; ++r) { C0[r] = 0.f; C1[r] = 0.f; }
            LAS unsigned char* ximg = L + wave * 17408;
            bf16x8 xr[16];
#pragma unroll
            for (int i = 0; i < 16; ++i) xr[i] = *(const bf16x8*)(xb + (size_t)(t0 + 4 * i + (lane >> 4)) * DM + 128 * wave + 8 * (lane & 15));
#pragma unroll
            for (int i = 0; i < 16; ++i) *(LAS bf16x8*)(ximg + (4 * i + (lane >> 4)) * 272 + 16 * (lane & 15)) = xr[i];
            const bf16* wp = wlb + (size_t)(c31 & 7) * DM + 128 * wave + 8 * hh;
#pragma unroll
            for (int ks = 0; ks < 8; ++ks) { const bf16x8 a0 = *(const LAS bf16x8*)(ximg + c31 * 272 + (16 * ks + 8 * hh) * 2), a1 = *(const LAS bf16x8*)(ximg + (32 + c31) * 272 + (16 * ks + 8 * hh) * 2);
                bf16x8 bw = *(const bf16x8*)(wp + 16 * ks); if (c31 >= 8) bw = (bf16x8){0, 0, 0, 0, 0, 0, 0, 0};
                C0 = MFMA32(a0, bw, C0); C1 = MFMA32(a1, bw, C1); }
            if (c31 < 8) {
#pragma unroll
                for (int r = 0; r < 16; ++r) { const int row = (r & 3) + 8 * (r >> 2) + 4 * hh; LP[(wave * 64 + row) * 8 + c31] = C0[r]; LP[(wave * 64 + 32 + row) * 8 + c31] = C1[r]; } }
        }
        LDS_WAIT(); __syncthreads();
        { const int tok = tid >> 3, j = tid & 7; float s = 0.f;
#pragma unroll
          for (int w = 0; w < 8; ++w) s += LP[(w * 64 + tok) * 8 + j];
          s *= __builtin_amdgcn_rsqf(pg8::ssq_val(sumsq[t0 + tok]) * (1.0f / 1024.0f) + 1e-6f);
          if (j < 4) bg[(size_t)(t0 + tok) * 8 + j] = 1.0f / (1.0f + __expf(-s));
          else { const float xx = s + F.dt_bias[l * 4 + j - 4], e = __expf(fminf(xx, 20.f));
               const float sp = xx > 20.f ? xx : (e < 0.01f ? e * (1.0f - e * (0.5f - e * 0.33333333f)) : __logf(1.0f + e));
               bg[(size_t)(t0 + tok) * 8 + j] = -__expf(F.a_log[l * 4 + j - 4]) * sp * L2E; } }
        LDS_WAIT(); __syncthreads();
        __syncthreads();
    }
}
#ifndef PREP_STAGE
#define PREP_STAGE -1
#endif
#ifndef PREP_N
#define PREP_N 0
#endif
#define PREPREP(id) (1 + ((PREP_STAGE) == (id) ? (PREP_N) : 0))
constexpr int CW_RF = 16384;
__device__ __forceinline__ unsigned* gdn_prep_item(Frame& F, int l, const pg8::ssq_t* sumsq, int item, int fl, unsigned* pend) {
    LAS unsigned char* L = F.lds;
    LAS float* LG = (LAS float*)(L + P_LG); LAS float* GC = (LAS float*)(L + P_GC); LAS float* LP = (LAS float*)(L + P_LP);
    LAS float* AM = (LAS float*)(L + P_AM); LAS float* TT = (LAS float*)(L + P_TT); LAS float* TC = (LAS float*)(L + P_TC); LAS float* XT = (LAS float*)(L + P_XT); LAS float* YT = (LAS float*)(L + P_YT);
    const bf16* pa = (const bf16*)(F.ws + WS_PA); const bf16* xb = (const bf16*)(F.ws + WS_XB);
    const bf16* wlb = (const bf16*)(F.ws + WS_WLOG) + (size_t)l * 8 * DM;
    const float* cw = F.conv_qkv + (size_t)l * 4 * 1536;
    int lane_o = F.lane; asm volatile("" : "+v"(lane_o));
    const int lane = lane_o, wave = F.wave, tid = wave * 64 + lane, hh = lane >> 5, c31 = lane & 31;
    const float SCALE = 0.08838834764831845f, L2E = 1.44269504089f;
    {
        const int h = item & 3, b = (item >> 2) & 7, n = item >> 5, t0 = b * SEQ + n * 64;
        float betav, gcv;
        { const float* bgp = (const float*)(F.ws + WS_BG) + (size_t)(t0 + lane) * 8; betav = bgp[h]; float g = bgp[4 + h];
#pragma unroll
            for (int o = 1; o < 64; o <<= 1) { const float t = __shfl_up(g, o); if (lane >= o) g += t; }
            gcv = g; if (wave == 0) { LG[h * 64 + lane] = betav; GC[h * 64 + lane] = g; } }
        {
            unsigned char* rec = rec_ptr(F, (b * 4 + h) * 64 + n);
            const long long dupd = (DUP_RECORDS && l == 0) ? (long long)((unsigned char*)F.out + (size_t)(((b * 4 + h) * 64 + n) % 1820) * REC_BYTES - rec) : 0ll;
            const LAS float* gc = GC + h * 64; const LAS float* beta = LG + h * 64;
            const float glast = __builtin_bit_cast(float, __builtin_amdgcn_readlane(__builtin_bit_cast(int, gcv), 63));
            for (int rp = 0; rp < PREPREP(1); ++rp) {
                unsigned rq[8], rk[8], rv[8];
#pragma unroll
                for (int r = 0; r < 8; ++r) { const bf16* p = pa + (size_t)(t0 + wave * 8 + r) * 1536 + h * 128 + 2 * lane; rq[r] = *(const unsigned*)p; rk[r] = *(const unsigned*)(p + 512); rv[r] = *(const unsigned*)(p + 1024); }
                #ifdef NO_SEAM_FIX
                const bool fixrows = false;
#else
                const bool fixrows = (wave == 0) && ((n & 3) == 0);
#endif
#pragma unroll
                for (int r = 0; r < 8; ++r) { const int i = wave * 8 + r;
                    float q0 = bflo(rq[r]), q1 = bfhi(rq[r]), k0 = bflo(rk[r]), k1 = bfhi(rk[r]), v0 = bflo(rv[r]), v1 = bfhi(rv[r]);
                    if (r < 3 && fixrows) {
                        const int pm = t0 >> 8; const bool halo = (pm & 15) != 0;
                        const float* qf = (const float*)(F.ws + WS_QFIRST) + (size_t)pm * 3 * 1536; const float* ql = (const float*)(F.ws + WS_QLAST) + (size_t)(halo ? pm - 1 : pm) * 3 * 1536;
                        float o[3][2];
#pragma unroll
                        for (int part = 0; part < 3; ++part)
#pragma unroll
                            for (int e = 0; e < 2; ++e) { const int c = part * 512 + h * 128 + 2 * lane + e; float s = 0.f;
#pragma unroll
                                for (int j = 0; j < 4; ++j) { const int idx = r - 3 + j;
                                    const float gval = (idx >= 0) ? qf[idx * 1536 + c] : (halo ? ql[(3 + idx) * 1536 + c] : 0.f);
                                    s += gval * cw[j * 1536 + c]; }
                                o[part][e] = pg8::silu_f(s); }
                        q0 = o[0][0]; q1 = o[0][1]; k0 = o[1][0]; k1 = o[1][1]; v0 = o[2][0]; v1 = o[2][1];
                    }
                    const float qn = __builtin_amdgcn_rsqf(wave_sum_dpp(q0 * q0 + q1 * q1) + 1e-6f), kn = __builtin_amdgcn_rsqf(wave_sum_dpp(k0 * k0 + k1 * k1) + 1e-6f);
                    q0 *= qn; q1 *= qn; k0 *= kn; k1 *= kn;
                    const float bi = __builtin_bit_cast(float, __builtin_amdgcn_readlane(__builtin_bit_cast(int, betav), i)), eg = __builtin_amdgcn_exp2f(__builtin_bit_cast(float, __builtin_amdgcn_readlane(__builtin_bit_cast(int, gcv), i)));
                    const int o2 = i * PI_ST + 4 * lane;
                    *(LAS unsigned*)(L + P_QB + o2) = pg8::cvt_pk_bf16(q0, q1); *(LAS unsigned*)(L + P_KB + o2) = pg8::cvt_pk_bf16(k0, k1);
                    *(LAS unsigned*)(L + P_RV + o2) = pg8::cvt_pk_bf16(bi * v0, bi * v1); *(LAS unsigned*)(L + P_RK + o2) = pg8::cvt_pk_bf16(bi * eg * k0, bi * eg * k1);
                }
            }
            VM_WAIT(); LDS_WAIT(); __syncthreads();
            if (pend && tid == 0) __hip_atomic_store(pend, 1u, __ATOMIC_RELAXED, __HIP_MEMORY_SCOPE_AGENT);
            for (int rp = 0; rp < PREPREP(2); ++rp)
            if (wave < 6) {
                const int blk = wave % 3, jt = (blk == 2) ? 1 : 0, it = (blk >= 1) ? 1 : 0;
                const bool isA = wave < 3;
                const LAS unsigned char* rimg = L + P_KB + (32 * jt + c31) * PI_ST + 16 * hh;
                const LAS unsigned char* cimg = L + (isA ? P_KB : P_QB) + (32 * it + c31) * PI_ST + 16 * hh;
                f32x16 C;
#pragma unroll
                for (int r = 0; r < 16; ++r) C[r] = 0.f;
#pragma unroll
                for (int ks = 0; ks < 8; ++ks) C = MFMA32(*(const LAS bf16x8*)(rimg + 32 * ks), *(const LAS bf16x8*)(cimg + 32 * ks), C);
                const int i = 32 * it + c31; const float gi = gc[i], bi = isA ? beta[i] : SCALE;
#pragma unroll
                for (int r = 0; r < 16; ++r) { const int j = 32 * jt + (r & 3) + 8 * (r >> 2) + 4 * hh; const bool ok = isA ? (i > j) : (i >= j);
                    C[r] = ok ? bi * C[r] * __builtin_amdgcn_exp2f(gi - gc[j]) : 0.f;
                    if (isA) AM[i * 68 + j] = C[r]; }
                if (!isA) {
#pragma unroll
                    for (int s = 0; s < 2; ++s) st_wt16(rec + R_AQ + ((it * 2 + jt) * 2 + s) * 1024 + lane * 16, __builtin_bit_cast(v4u, pack8(C, s))); }
            } else {
                LAS v4u* z = (LAS v4u*)(L + (wave == 6 ? P_TT : P_TC));
#pragma unroll
                for (int q = 0; q < 17; ++q) z[q * 64 + lane] = (v4u){0u, 0u, 0u, 0u};
                if (wave == 6 && lane == 0) __hip_atomic_store((float*)(rec + R_DL), __builtin_amdgcn_exp2f(glast), __ATOMIC_RELAXED, __HIP_MEMORY_SCOPE_AGENT);
            }
            LDS_WAIT(); __syncthreads();
            for (int rp = 0; rp < PREPREP(3); ++rp) {
            if (wave == 0) {
                const int pp = lane >> 4, c = lane & 15; const LAS float* Ab = AM + (16 * pp) * 68 + 16 * pp;
                float acc[16];
#pragma unroll
                for (int i = 0; i < 16; ++i) acc[i] = (i == c) ? 1.f : 0.f;
#pragma unroll
                for (int j = 0; j < 15; ++j) { const float sj = acc[j];
#pragma unroll
                    for (int i = j + 1; i < 16; ++i) acc[i] -= Ab[i * 68 + j] * sj; }
#pragma unroll
                for (int i = 0; i < 16; ++i) TT[(16 * pp + i) * 68 + 16 * pp + c] = acc[i];
#pragma unroll
                for (int q = 0; q < 4; ++q) *(LAS f32x4*)(TC + (16 * pp + c) * 68 + 16 * pp + 4 * q) = (f32x4){acc[4 * q], acc[4 * q + 1], acc[4 * q + 2], acc[4 * q + 3]};
            } else if (wave < 5) {
#pragma unroll 2
                for (int f = (wave - 1) * 4; f < (wave - 1) * 4 + 4; ++f) { const int s = f & 1, t = (f >> 1) & 3, mi = f >> 3, i = 32 * mi + c31; const float sc = SCALE * __builtin_amdgcn_exp2f(gc[i]);
                    const LAS unsigned char* p = L + P_QB + i * PI_ST + (32 * t + 16 * s + 4 * hh) * 2; const v2u lo = *(const LAS v2u*)p, hi = *(const LAS v2u*)(p + 16);
                    v4u o; o.x = pg8::cvt_pk_bf16(bflo(lo.x) * sc, bfhi(lo.x) * sc); o.y = pg8::cvt_pk_bf16(bflo(lo.y) * sc, bfhi(lo.y) * sc); o.z = pg8::cvt_pk_bf16(bflo(hi.x) * sc, bfhi(hi.x) * sc); o.w = pg8::cvt_pk_bf16(bflo(hi.y) * sc, bfhi(hi.y) * sc);
                    st_wt16(rec + R_QDF(f) + lane * 16, o); }
            } else {
                const int f0 = (wave == 5) ? 0 : (wave == 6 ? 5 : 10), f1 = (wave == 5) ? 5 : (wave == 6 ? 10 : 16);
                for (int f = f0; f < f1; ++f) { const int s = f & 1, mi = (f >> 1) & 1, t = f >> 2, i0 = 32 * mi + 16 * s + 4 * hh;
                    const bf16x8 v = tr_frag(L + P_KB, i0, 8, 32 * t, lane); const v4u vw = __builtin_bit_cast(v4u, v);
                    const f32x4 ga = *(const LAS f32x4*)(gc + i0), gb = *(const LAS f32x4*)(gc + i0 + 8);
                    v4u o; o.x = pg8::cvt_pk_bf16(bflo(vw.x) * __builtin_amdgcn_exp2f(glast - ga[0]), bfhi(vw.x) * __builtin_amdgcn_exp2f(glast - ga[1]));
                    o.y = pg8::cvt_pk_bf16(bflo(vw.y) * __builtin_amdgcn_exp2f(glast - ga[2]), bfhi(vw.y) * __builtin_amdgcn_exp2f(glast - ga[3]));
                    o.z = pg8::cvt_pk_bf16(bflo(vw.z) * __builtin_amdgcn_exp2f(glast - gb[0]), bfhi(vw.z) * __builtin_amdgcn_exp2f(glast - gb[1]));
                    o.w = pg8::cvt_pk_bf16(bflo(vw.w) * __builtin_amdgcn_exp2f(glast - gb[2]), bfhi(vw.w) * __builtin_amdgcn_exp2f(glast - gb[3]));
                    st_wt16(rec + R_KT + f * 1024 + lane * 16, o); }
            }
            LDS_WAIT(); __syncthreads();
            { const int pr = tid >> 8, i = (tid >> 4) & 15, c = tid & 15, p16 = 32 * pr + 16, q16 = 32 * pr;
              { const LAS float* ar = AM + (p16 + i) * 68 + q16; const LAS float* dc = TC + (q16 + c) * 68 + q16; float x = 0.f;
#pragma unroll
                for (int k4 = 0; k4 < 4; ++k4) { const f32x4 a = *(const LAS f32x4*)(ar + 4 * k4), d = *(const LAS f32x4*)(dc + 4 * k4); x += a[0] * d[0] + a[1] * d[1] + a[2] * d[2] + a[3] * d[3]; }
                XT[pr * 320 + c * 20 + i] = x; }
              LDS_WAIT(); __syncthreads();
              { const LAS float* dr = TT + (p16 + i) * 68 + p16; const LAS float* xc = XT + pr * 320 + c * 20; float t = 0.f;
#pragma unroll
                for (int k4 = 0; k4 < 4; ++k4) { const f32x4 a = *(const LAS f32x4*)(dr + 4 * k4), d = *(const LAS f32x4*)(xc + 4 * k4); t -= a[0] * d[0] + a[1] * d[1] + a[2] * d[2] + a[3] * d[3]; }
                TT[(p16 + i) * 68 + q16 + c] = t; TC[(q16 + c) * 68 + p16 + i] = t; }
              LDS_WAIT(); __syncthreads(); }
            { const int i = tid >> 4, c0 = 2 * (tid & 15);
              { const LAS float* ar = AM + (32 + i) * 68; const LAS float* t0 = TC + c0 * 68; const LAS float* t1 = t0 + 68; float y0 = 0.f, y1 = 0.f;
#pragma unroll
                for (int k4 = 0; k4 < 8; ++k4) { const f32x4 a = *(const LAS f32x4*)(ar + 4 * k4), d0 = *(const LAS f32x4*)(t0 + 4 * k4), d1 = *(const LAS f32x4*)(t1 + 4 * k4);
                    y0 += a[0] * d0[0] + a[1] * d0[1] + a[2] * d0[2] + a[3] * d0[3]; y1 += a[0] * d1[0] + a[1] * d1[1] + a[2] * d1[2] + a[3] * d1[3]; }
                YT[c0 * 36 + i] = y0; YT[(c0 + 1) * 36 + i] = y1; }
              LDS_WAIT(); __syncthreads();
              { const LAS float* tr = TT + (32 + i) * 68 + 32; const LAS float* y0p = YT + c0 * 36; const LAS float* y1p = y0p + 36; float r0 = 0.f, r1 = 0.f;
#pragma unroll
                for (int k4 = 0; k4 < 8; ++k4) { const f32x4 a = *(const LAS f32x4*)(tr + 4 * k4), d0 = *(const LAS f32x4*)(y0p + 4 * k4), d1 = *(const LAS f32x4*)(y1p + 4 * k4);
                    r0 -= a[0] * d0[0] + a[1] * d0[1] + a[2] * d0[2] + a[3] * d0[3]; r1 -= a[0] * d1[0] + a[1] * d1[1] + a[2] * d1[2] + a[3] * d1[3]; }
                TT[(32 + i) * 68 + c0] = r0; TT[(32 + i) * 68 + c0 + 1] = r1; }
              LDS_WAIT(); __syncthreads(); }
            }
            for (int rp = 0; rp < PREPREP(4); ++rp) {
            {
                const int mi = wave & 1, sl = wave >> 1;
                f32x16 C;
#pragma unroll
                for (int r = 0; r < 16; ++r) C[r] = 0.f;
#pragma unroll
                for (int ks = 0; ks < 4; ++ks) { const LAS float* tp = TT + (32 * mi + c31) * 68 + 16 * ks + 8 * hh;
                    C = MFMA32(cvt8(*(const LAS f32x4*)tp, *(const LAS f32x4*)(tp + 4)), tr_frag(L + P_RV, 16 * ks + 8 * hh, 4, 32 * sl, lane), C); }
                unsigned char* up = rec + R_U + ((sl * 2 + mi) * 64 + lane) * 32;
                st_wt16(up, __builtin_bit_cast(v4u, pack8(C, 0))); st_wt16(up + 16, __builtin_bit_cast(v4u, pack8(C, 1)));
            }
            {
                const int t = wave & 3, mi = wave >> 2;
                f32x16 C;
#pragma unroll
                for (int r = 0; r < 16; ++r) C[r] = 0.f;
#pragma unroll
                for (int ks = 0; ks < 4; ++ks) { const LAS float* tp = TT + (32 * mi + c31) * 68 + 16 * ks + 8 * hh;
                    C = MFMA32(tr_frag(L + P_RK, 16 * ks + 8 * hh, 4, 32 * t, lane), cvt8(*(const LAS f32x4*)tp, *(const LAS f32x4*)(tp + 4)), C); }
#pragma unroll
                for (int r = 0; r < 16; ++r) C[r] = -C[r];
#pragma unroll
                for (int s = 0; s < 2; ++s) st_wt16(rec + R_WNF((mi * 4 + t) * 2 + s) + lane * 16, __builtin_bit_cast(v4u, pack8(C, s)));
            }
            }
            LDS_WAIT(); __syncthreads();
        }
        return (unsigned*)(F.ws + WS_CTL) + CW_RF + ((fl * 8 + b) * 4 + h) * 64 + n;
    }
}

constexpr int SC_OX = 8 * QTR, OXS = 136, OX_BYTES = 64 * OXS * 2;
__device__ __forceinline__ void gdn_out_rows(Frame& F, const LAS unsigned char* ox, int pw, int l, int h, size_t tok0, const v4u (&z)[2][4]) {
    const int lane = F.lane, q = lane & 3; bf16* y = (bf16*)(Y_BASE(F));
#pragma unroll
    for (int ps = 0; ps < 2; ++ps) { const int i = 32 * pw + 16 * ps + (lane >> 2);
        const LAS v4u* src = (const LAS v4u*)(ox + i * (OXS * 2) + q * 64); v4u o4[4]; float ss = 0.f;
#pragma unroll
        for (int k = 0; k < 4; ++k) { o4[k] = src[k];
            const float a0 = bflo(o4[k].x), a1 = bfhi(o4[k].x), a2 = bflo(o4[k].y), a3 = bfhi(o4[k].y), a4 = bflo(o4[k].z), a5 = bfhi(o4[k].z), a6 = bflo(o4[k].w), a7 = bfhi(o4[k].w);
            ss += (a0 * a0 + a1 * a1) + (a2 * a2 + a3 * a3) + (a4 * a4 + a5 * a5) + (a6 * a6 + a7 * a7); }
        ss += __shfl_xor(ss, 1); ss += __shfl_xor(ss, 2);
        const float rs = __builtin_amdgcn_rsqf(ss * (1.0f / 128.0f) + 1e-6f);
        bf16* yp = y + (tok0 + i) * 1024 + h * 128 + q * 32;
#pragma unroll
        for (int k = 0; k < 4; ++k) { const unsigned ow[4] = {o4[k].x, o4[k].y, o4[k].z, o4[k].w}; const unsigned zw[4] = {z[ps][k].x, z[ps][k].y, z[ps][k].z, z[ps][k].w}; unsigned rw[4];
#pragma unroll
            for (int e = 0; e < 4; ++e) rw[e] = pg8::cvt_pk_bf16(bflo(ow[e]) * rs * bflo(zw[e]), bfhi(ow[e]) * rs * bfhi(zw[e]));
            v4u r; r.x = rw[0]; r.y = rw[1]; r.z = rw[2]; r.w = rw[3]; *(v4u*)(yp + 8 * k) = r; }
    }
}
__device__ __forceinline__ void scan_wait_group(Frame& F, int l, int bh, int g) {
    unsigned* fp = (unsigned*)(F.ws + WS_CTL) + CW_RF + (l * 32 + bh) * 64 + g * 8 + (F.lane & 7);
    for (unsigned sp = 0; sp < (1u << 22); ++sp) { const unsigned v = __hip_atomic_load(fp, __ATOMIC_RELAXED, __HIP_MEMORY_SCOPE_AGENT); if (__ballot(v == 0u) == 0ull) break; __builtin_amdgcn_s_sleep(2); }
    __builtin_amdgcn_fence(__ATOMIC_ACQUIRE, "agent"); asm volatile("s_waitcnt vmcnt(0)" ::: "memory");
}
__device__ __forceinline__ void phase_gdn_scan(Frame& F, int l, int fl) {
    if (F.bid >= 32) return;
    const int b = F.bid >> 2, h = F.bid & 3, wave = F.wave, lane = F.lane;
    if (wave == 4) scan_wait_group(F, fl, b * 4 + h, 0);
    __syncthreads();
    const int rec0 = (b * 4 + h) * 64;
    const size_t tok00 = (size_t)b * SEQ;
    if (wave >= 6) {
        const int pw = wave - 6, q = lane & 3; const bf16* prest = (const bf16*)(F.ws + WS_PREST);
        v4u zc[2][4], zn[2][4];
#pragma unroll
        for (int ps = 0; ps < 2; ++ps)
#pragma unroll
            for (int k = 0; k < 4; ++k) zc[ps][k] = (v4u){0u, 0u, 0u, 0u};
        __syncthreads();
        for (int n = 0; n < 64; ++n) {
#pragma unroll
            for (int ps = 0; ps < 2; ++ps) { const v4u* zp = (const v4u*)(prest + (tok00 + n * 64 + 32 * pw + 16 * ps + (lane >> 2)) * 2048 + h * 128 + q * 32);
#pragma unroll
                for (int k = 0; k < 4; ++k) zn[ps][k] = zp[k]; }
            if (n >= 1) gdn_out_rows(F, F.lds + SC_OX + ((n - 1) & 1) * OX_BYTES, pw, l, h, tok00 + (n - 1) * 64, zc);
            LDS_WAIT(); __syncthreads(); __syncthreads(); __syncthreads(); __syncthreads();
#pragma unroll
            for (int ps = 0; ps < 2; ++ps)
#pragma unroll
                for (int k = 0; k < 4; ++k) zc[ps][k] = zn[ps][k];
        }
        gdn_out_rows(F, F.lds + SC_OX + (63 & 1) * OX_BYTES, pw, l, h, tok00 + 63 * 64, zc);
    } else if (wave >= 4) {
        const int lw = wave - 4;
        auto issue = [&](int G) {
            const unsigned char* src = rec_ptr(F, rec0 + (G >> 2)) + (G & 3) * QTR + lw * 7168 + lane * 16; LAS unsigned char* dst = F.lds + (G & 7) * QTR + lw * 7168;
#pragma unroll
            for (int i = 0; i < 7; ++i) __builtin_amdgcn_global_load_lds((const unsigned*)(src + i * 1024), (LAS unsigned*)(dst + i * 1024), 16, 0, 0);
        };
        for (int G = 0; G < 7; ++G) issue(G);
        asm volatile("s_waitcnt vmcnt(42)" ::: "memory"); __builtin_amdgcn_s_barrier(); asm volatile("" ::: "memory");
        for (int G = 0; G < 256; ++G) {
            if (G + 7 < 256) issue(G + 7);
            if (lw == 0 && ((G + 12) & 31) == 0 && G + 12 < 256) scan_wait_group(F, fl, b * 4 + h, (G + 12) >> 5);
            const int left = 255 - G;
            if (left >= 7) asm volatile("s_waitcnt vmcnt(42)" ::: "memory");
            else if (left == 6) asm volatile("s_waitcnt vmcnt(35)" ::: "memory"); else if (left == 5) asm volatile("s_waitcnt vmcnt(28)" ::: "memory");
            else if (left == 4) asm volatile("s_waitcnt vmcnt(21)" ::: "memory"); else if (left == 3) asm volatile("s_waitcnt vmcnt(14)" ::: "memory");
            else if (left == 2) asm volatile("s_waitcnt vmcnt(7)" ::: "memory"); else asm volatile("s_waitcnt vmcnt(0)" ::: "memory");
            __builtin_amdgcn_s_barrier(); asm volatile("" ::: "memory");
        }
    } else {
        const int sl = wave, hh = lane >> 5, col = lane & 31;
        f32x16 S[4]; bf16x8 Sb[4][2];
#pragma unroll
        for (int t = 0; t < 4; ++t) {
#pragma unroll
            for (int r = 0; r < 16; ++r) S[t][r] = 0.f;
            Sb[t][0] = (bf16x8){0, 0, 0, 0, 0, 0, 0, 0}; Sb[t][1] = Sb[t][0]; }
        v4u Uc[2][2], Un[2][2];
#pragma unroll
        for (int mi = 0; mi < 2; ++mi) { const v4u* up = (const v4u*)(rec_ptr(F, rec0) + R_U + ((sl * 2 + mi) * 64 + lane) * 32); Uc[mi][0] = up[0]; Uc[mi][1] = up[1]; }
        __syncthreads();
        for (int n = 0; n < 64; ++n) {
#ifdef SCAN_DELAY
            __builtin_amdgcn_s_sleep(SCAN_DELAY);
#endif
#define FRAG(fr) (*(const LAS bf16x8*)(F.lds + (((4 * n + (fr) / 14) & 7) * QTR) + ((fr) % 14) * 1024 + lane * 16))
            f32x16 Vp[2], O[2];
#pragma unroll
            for (int mi = 0; mi < 2; ++mi) {
#pragma unroll
                for (int g2 = 0; g2 < 2; ++g2) { const v4u u = Uc[mi][g2];
                    Vp[mi][8 * g2 + 0] = bflo(u.x); Vp[mi][8 * g2 + 1] = bfhi(u.x); Vp[mi][8 * g2 + 2] = bflo(u.y); Vp[mi][8 * g2 + 3] = bfhi(u.y);
                    Vp[mi][8 * g2 + 4] = bflo(u.z); Vp[mi][8 * g2 + 5] = bfhi(u.z); Vp[mi][8 * g2 + 6] = bflo(u.w); Vp[mi][8 * g2 + 7] = bfhi(u.w); }
#pragma unroll
                for (int r = 0; r < 16; ++r) O[mi][r] = 0.f; }
            if (n + 1 < 64) {
#pragma unroll
                for (int mi = 0; mi < 2; ++mi) { const v4u* up = (const v4u*)(rec_ptr(F, rec0 + n + 1) + R_U + ((sl * 2 + mi) * 64 + lane) * 32); Un[mi][0] = up[0]; Un[mi][1] = up[1]; } }
#pragma unroll
            for (int pf = 0; pf < 16; ++pf) { const int mi = pf >> 3, t = (pf >> 1) & 3, s = pf & 1;
                const bf16x8 aw = FRAG(2 * pf), aq = FRAG(2 * pf + 1);
                Vp[mi] = MFMA32(aw, Sb[t][s], Vp[mi]); O[mi] = MFMA32(aq, Sb[t][s], O[mi]);
                if (pf == 6 || pf == 13) { LDS_WAIT(); __syncthreads(); } }
            bf16x8 Vb[2][2];
#pragma unroll
            for (int mi = 0; mi < 2; ++mi) { Vb[mi][0] = pack8(Vp[mi], 0); Vb[mi][1] = pack8(Vp[mi], 1); }
#pragma unroll
            for (int mo = 0; mo < 2; ++mo)
#pragma unroll
                for (int mi = 0; mi <= mo; ++mi)
#pragma unroll
                    for (int s = 0; s < 2; ++s) { const bf16x8 a = FRAG(32 + (mo * 2 + mi) * 2 + s); O[mo] = MFMA32(a, Vb[mi][s], O[mo]); }
            const float dl = *(const LAS float*)(F.lds + (((4 * n + 2) & 7) * QTR) + (34 - 28) * 1024);
#pragma unroll
            for (int t = 0; t < 4; ++t) {
#pragma unroll
                for (int r = 0; r < 16; ++r) S[t][r] *= dl;
#pragma unroll
                for (int mi = 0; mi < 2; ++mi)
#pragma unroll
                    for (int s = 0; s < 2; ++s) { const int kf = (t * 2 + mi) * 2 + s; const bf16x8 a = FRAG(40 + kf); S[t] = MFMA32(a, Vb[mi][s], S[t]);
                        if (kf == 1) { LDS_WAIT(); __syncthreads(); } }
                Sb[t][0] = pack8(S[t], 0); Sb[t][1] = pack8(S[t], 1); }
#undef FRAG
            LAS bf16* ox = (LAS bf16*)(F.lds + SC_OX + (n & 1) * OX_BYTES);
#pragma unroll
            for (int mo = 0; mo < 2; ++mo)
#pragma unroll
                for (int r = 0; r < 16; ++r) ox[(32 * mo + (r & 3) + 8 * (r >> 2) + 4 * hh) * OXS + 32 * sl + col] = (bf16)(pg8::cvt_pk_bf16(O[mo][r], 0.f) & 0xffffu);
            LDS_WAIT(); __syncthreads();
#pragma unroll
            for (int mi = 0; mi < 2; ++mi) { Uc[mi][0] = Un[mi][0]; Uc[mi][1] = Un[mi][1]; }
        }
    }
}
constexpr int AT_OS = 0, AT_OSTRIDE = 136, AT_M = 512 * AT_OSTRIDE, AT_L = AT_M + 2048, AT_V = AT_L + 2048, AT_VROW = 144, AT_VBYTES = 32 * AT_VROW, AT_BC = AT_V + 16 * AT_VBYTES;
#ifndef MIX_REP_SHIFT_P
#define MIX_REP_SHIFT_P 0
#endif
#ifndef MIX_REP_SHIFT_A
#define MIX_REP_SHIFT_A 0
#endif
#ifndef MIX_REP_PREP
#define MIX_REP_PREP 0
#endif
#ifndef MIX_DENSE_MODE
#define MIX_DENSE_MODE 0
#endif
#ifndef MIX_DENSE_NOBAR
#define MIX_DENSE_NOBAR false
#endif
#ifndef MIX_DENSE_LO
#define MIX_DENSE_LO 0
#endif
#ifndef MIX_DENSE_HI
#define MIX_DENSE_HI 3
#endif
#ifndef MIX_REP_ATTN
#define MIX_REP_ATTN 0
#endif
constexpr int CW_ATTN = 8192;

template <int MODE = 0>
__device__ __forceinline__ void attn_qtile(Frame& F, int cfg, int d, int rr, int i0, int b, int h, int P0, float c2, int nd, int nrr, int ni0) {
#ifdef ATTN_NO_OPAQUE
    const int lane = F.lane, qi = lane & 31, hh = lane >> 5;
#else
    int lane_o = F.lane; asm volatile("" : "+v"(lane_o));
    const int lane = lane_o, qi = lane & 31, hh = lane >> 5;
#endif
    const bf16* prest = (const bf16*)(F.ws + WS_PREST);
    const size_t tokb = (size_t)b * SEQ;
    const int qpos = (i0 + qi) * d + rr;
    bf16x8 Qf[4], Qr[4];
#pragma unroll
    for (int i = 0; i < 4; ++i) { const int qrow = (lane >> 3) + 8 * i; Qr[i] = *(const bf16x8*)(prest + (tokb + (size_t)((i0 + qrow) * d + rr)) * 2048 + 512 + h * 64 + 8 * (lane & 7)); }
    float m = -1e30f, lsum = 0.f; f32x16 OT[2];
#pragma unroll
    for (int r = 0; r < 16; ++r) { OT[0][r] = 0.f; OT[1][r] = 0.f; }
    const int base = i0 - 128, kt_lo = base < 0 ? (-base) >> 5 : 0;
    const float c1 = 0.125f * 1.44269504089f;
    LAS unsigned char* vb0 = F.lds + AT_V + F.wave * 2 * AT_VBYTES;
    bf16x8 KB3[3][4]; v4u VB3[3][4];
#define AT_KT(q) (4 - (q))
#define AT_LOADK(q) do { const int kk_ = AT_KT(q) < kt_lo ? kt_lo : AT_KT(q); \
        _Pragma("unroll") for (int i = 0; i < 4; ++i) { const int key_ = (lane >> 3) + 8 * i; \
            KB3[(q) % 3][i] = *(const bf16x8*)(prest + (tokb + (size_t)((base + 32 * kk_ + key_) * d + rr)) * 2048 + 1024 + h * 64 + 8 * (lane & 7)); } } while (0)
#define AT_LOADV(q) do { const int kk_ = AT_KT(q) < kt_lo ? kt_lo : AT_KT(q); \
        _Pragma("unroll") for (int i = 0; i < 4; ++i) { const int key_ = (lane >> 3) + 8 * i; \
            VB3[(q) % 3][i] = *(const v4u*)(prest + (tokb + (size_t)((base + 32 * kk_ + key_) * d + rr)) * 2048 + 1536 + h * 64 + 8 * (lane & 7)); } } while (0)
#define AT_QK(q, dst) do { _Pragma("unroll") for (int r = 0; r < 16; ++r) dst[r] = 0.f; \
        _Pragma("unroll") for (int i = 0; i < 4; ++i) *(LAS bf16x8*)(vb0 + ((lane >> 3) + 8 * i) * AT_VROW + 16 * (lane & 7)) = KB3[(q) % 3][i]; \
        if (MODE < 3) { _Pragma("unroll") for (int ks = 0; ks < 4; ++ks) dst = MFMA32(*(const LAS bf16x8*)(vb0 + qi * AT_VROW + (16 * ks + 8 * hh) * 2), Qf[ks], dst); } \
        else { _Pragma("unroll") for (int ks = 0; ks < 4; ++ks) asm volatile("" :: "v"(KB3[(q) % 3][ks])); } } while (0)
#define AT_SOFTPV(q, ST) do { \
        if (MODE >= 2) { _Pragma("unroll") for (int i = 0; i < 4; ++i) asm volatile("" :: "v"(VB3[(q) % 3][i])); if (MODE == 2) { _Pragma("unroll") for (int r = 0; r < 16; ++r) OT[0][r] += ST[r]; } break; } \
        LAS unsigned char* vb = vb0 + AT_VBYTES; \
        _Pragma("unroll") for (int i = 0; i < 4; ++i) *(LAS v4u*)(vb + ((lane >> 3) + 8 * i) * AT_VROW + 16 * (lane & 7)) = VB3[(q) % 3][i]; \
        const float hh4_ = (AT_KT(q) >= kt_lo) ? hh4 : -INFINITY; \
        float mx_[4] = {-INFINITY, -INFINITY, -INFINITY, -INFINITY}; \
        _Pragma("unroll") for (int r = 0; r < 16; ++r) { const int rowoff = (r & 3) + 8 * (r >> 2); \
            float t = __builtin_fmaf(ST[r], c1c2, hh4_) + (float)(32 * AT_KT(q) + rowoff); \
            if (AT_KT(q) == 0) t = (rowoff + 4 * hh >= qi) ? t : -INFINITY; \
            if (AT_KT(q) == 4) t = (rowoff + 4 * hh <= qi) ? t : -INFINITY; \
            ST[r] = t; mx_[r & 3] = fmaxf(mx_[r & 3], t); } \
        f32x16 P_; \
        if (MODE == 1) { _Pragma("unroll") for (int r = 0; r < 16; ++r) P_[r] = ST[r]; } else \
        if ((q) == 0) { float tmax = fmaxf(fmaxf(mx_[0], mx_[1]), fmaxf(mx_[2], mx_[3])); tmax = fmaxf(tmax, __shfl_xor(tmax, 32)); m = tmax; nm = -c2 * m; \
            _Pragma("unroll") for (int r = 0; r < 16; ++r) P_[r] = __builtin_amdgcn_exp2f(__builtin_fmaf(ST[r], c2, nm)); } \
        else { \
            _Pragma("unroll") for (int r = 0; r < 16; ++r) P_[r] = __builtin_amdgcn_exp2f(__builtin_fmaf(ST[r], c2, nm)); \
            float tmax = fmaxf(fmaxf(mx_[0], mx_[1]), fmaxf(mx_[2], mx_[3])); tmax = fmaxf(tmax, __shfl_xor(tmax, 32)); \
            if (__ballot(tmax > m + thr) != 0ull) { const float mnew = fmaxf(m, tmax), corr = __builtin_amdgcn_exp2f(c2 * (m - mnew)); m = mnew; nm = -c2 * m; lsum *= corr; \
                _Pragma("unroll") for (int r = 0; r < 16; ++r) { OT[0][r] *= corr; OT[1][r] *= corr; P_[r] = __builtin_amdgcn_exp2f(__builtin_fmaf(ST[r], c2, nm)); } } } \
        float ps_[4] = {0.f, 0.f, 0.f, 0.f}; \
        _Pragma("unroll") for (int r = 0; r < 16; ++r) ps_[r & 3] += P_[r]; \
        lsum += (ps_[0] + ps_[1]) + (ps_[2] + ps_[3]); \
        const bf16x8 Pb0 = pack8(P_, 0), Pb1 = pack8(P_, 1); \
        _Pragma("unroll") for (int dvt = 0; dvt < 2; ++dvt) \
            _Pragma("unroll") for (int s = 0; s < 2; ++s) { \
                const int col = 32 * dvt + 16 * ((lane >> 4) & 1) + 4 * (lane & 3), key0 = 16 * s + 4 * hh + ((lane & 15) >> 2); \
                const s16x4 lo = __builtin_amdgcn_ds_read_tr16_b64_v4i16((LAS s16x4*)(vb + key0 * AT_VROW + col * 2)); \
                const s16x4 hi = __builtin_amdgcn_ds_read_tr16_b64_v4i16((LAS s16x4*)(vb + (key0 + 8) * AT_VROW + col * 2)); \
                const bf16x8 vt = {lo[0], lo[1], lo[2], lo[3], hi[0], hi[1], hi[2], hi[3]}; \
                OT[dvt] = MFMA32(vt, s == 0 ? Pb0 : Pb1, OT[dvt]); } } while (0)
    const float hh4 = (float)(4 * hh), c1c2 = c1 / c2, thr = 8.0f / c2; float nm = 0.f;
    f32x16 SA, SB;
    AT_LOADK(0); AT_LOADK(1); AT_LOADV(0); AT_LOADK(2); AT_LOADV(1);
    {   LAS unsigned char* qimg = F.lds + AT_V + F.wave * 2 * AT_VBYTES;
        asm volatile("" ::: "memory");
#pragma unroll
        for (int i = 0; i < 4; ++i) { const int qrow = (lane >> 3) + 8 * i; *(LAS bf16x8*)(qimg + qrow * AT_VROW + 16 * (lane & 7)) = Qr[i]; }
#pragma unroll
        for (int ks = 0; ks < 4; ++ks) Qf[ks] = *(const LAS bf16x8*)(qimg + qi * AT_VROW + (16 * ks + 8 * hh) * 2);
        asm volatile("s_waitcnt lgkmcnt(0)" ::: "memory");
    }
#define AT_OK(q) (MODE != 0 || AT_KT(q) >= kt_lo)
    AT_QK(0, SA);
    if (AT_OK(1)) AT_QK(1, SB); AT_LOADK(3); AT_LOADV(2); AT_SOFTPV(0, SA);
    if (AT_OK(2)) AT_QK(2, SA); AT_LOADK(4); AT_LOADV(3); if (AT_OK(1)) AT_SOFTPV(1, SB);
    if (AT_OK(3)) AT_QK(3, SB);              AT_LOADV(4); if (AT_OK(2)) AT_SOFTPV(2, SA);
    if (AT_OK(4)) AT_QK(4, SA);                           if (AT_OK(3)) AT_SOFTPV(3, SB);
                                                          if (AT_OK(4)) AT_SOFTPV(4, SA);
#undef AT_OK
#undef AT_KT
#undef AT_LOADK
#undef AT_LOADV
#undef AT_QK
#undef AT_SOFTPV
    m = c2 * (m - (float)(qi + 128));
    const float ltot = lsum + __shfl_xor(lsum, 32);
    const int slot = qpos - P0;
    LAS float* Ms = (LAS float*)(F.lds + AT_M); LAS float* Ls = (LAS float*)(F.lds + AT_L);
    LAS unsigned char* os = F.lds + AT_OS + slot * AT_OSTRIDE;
    if (cfg == 0) {
        if (hh == 0) { Ms[slot] = m; Ls[slot] = ltot; }
#pragma unroll
        for (int dvt = 0; dvt < 2; ++dvt)
#pragma unroll
            for (int g = 0; g < 4; ++g) { v2u w; w.x = pg8::cvt_pk_bf16(OT[dvt][4 * g], OT[dvt][4 * g + 1]); w.y = pg8::cvt_pk_bf16(OT[dvt][4 * g + 2], OT[dvt][4 * g + 3]);
                *(LAS v2u*)(os + (32 * dvt + 8 * g + 4 * hh) * 2) = w; }
    } else {
        const float m0 = Ms[slot], l0 = Ls[slot], mn = fmaxf(m, m0), a = __builtin_amdgcn_exp2f(m - mn), b0 = __builtin_amdgcn_exp2f(m0 - mn), ln = ltot * a + l0 * b0;
        const float inv = (cfg == 2) ? 1.0f / ln : 1.0f;
#pragma unroll
        for (int dvt = 0; dvt < 2; ++dvt)
#pragma unroll
            for (int g = 0; g < 4; ++g) { const int dv0 = 32 * dvt + 8 * g + 4 * hh; const v2u o = *(const LAS v2u*)(os + dv0 * 2);
                const float e0 = (OT[dvt][4 * g] * a + bflo(o.x) * b0) * inv, e1 = (OT[dvt][4 * g + 1] * a + bfhi(o.x) * b0) * inv,
                            e2 = (OT[dvt][4 * g + 2] * a + bflo(o.y) * b0) * inv, e3 = (OT[dvt][4 * g + 3] * a + bfhi(o.y) * b0) * inv;
                v2u w; w.x = pg8::cvt_pk_bf16(e0, e1); w.y = pg8::cvt_pk_bf16(e2, e3);
                if (cfg == 2) *(LAS v2u*)(vb0 + qi * AT_VROW + dv0 * 2) = w; else *(LAS v2u*)(os + dv0 * 2) = w; }
        if (cfg == 1 && hh == 0) { Ms[slot] = mn; Ls[slot] = ln; }
        if (cfg == 2) {
#pragma unroll
            for (int i = 0; i < 4; ++i) { const int row = (lane >> 3) + 8 * i;
                *(v4u*)((bf16*)(Y_BASE(F)) + (tokb + (size_t)((i0 + row) * d + rr)) * 1024 + 512 + h * 64 + 8 * (lane & 7)) = *(const LAS v4u*)(vb0 + row * AT_VROW + 16 * (lane & 7)); } }
    }
}
template <int CFG, bool NOBAR = false, int MODE = 0>
__device__ __forceinline__ void attn_cfg(Frame& F, int b, int h, int P0, float slope_l2e) {
    constexpr int d = (CFG == 0) ? 16 : (CFG == 1 ? 4 : 1);
#pragma unroll 1
    for (int tt = 0; tt < 2; ++tt) { const int Tq = 2 * F.wave + tt;
        const int rr = (CFG == 0) ? Tq : (CFG == 1 ? (Tq >> 2) : 0), t = (CFG == 0) ? 0 : (CFG == 1 ? (Tq & 3) : Tq);
        attn_qtile<MODE>(F, CFG, d, rr, P0 / d + 32 * t, b, h, P0, slope_l2e * (float)d, 0, 0, 0); }
    if (!NOBAR) { LDS_WAIT(); __syncthreads(); }
}
template <int CFG_LO = 0, int CFG_HI = 3, bool NOBAR = false, int MODE = 0>
__device__ __forceinline__ void attn_item(Frame& F, unsigned item) {
    const int b = item >> 6, h = (item >> 3) & 7, P0 = (int)(item & 7) * 512;
    const float slope_l2e = exp2f(-(float)(h + 1)) * 1.44269504089f;
    if (CFG_LO <= 0 && 0 < CFG_HI) attn_cfg<0, NOBAR, MODE>(F, b, h, P0, slope_l2e);
    if (CFG_LO <= 1 && 1 < CFG_HI) attn_cfg<1, NOBAR, MODE>(F, b, h, P0, slope_l2e);
    if (CFG_LO <= 2 && 2 < CFG_HI) attn_cfg<2, NOBAR, MODE>(F, b, h, P0, slope_l2e);
}
#ifndef ATTN_XCD_QUEUES
#define ATTN_XCD_QUEUES 1
#endif
__device__ __forceinline__ void phase_mixer(Frame& F, int l, const pg8::ssq_t* sumsq, int qslot) {
    phase_gdn_scan(F, l, qslot);
    unsigned* ctr = (unsigned*)(F.ws + WS_CTL) + CW_ATTN + 64 * qslot; unsigned* cA = ctr + 32;
    volatile LAS unsigned* bc = (volatile LAS unsigned*)(F.lds + LDSCTL_OFF + 64);
    unsigned* pend = nullptr;
    __syncthreads();
    if (F.tid == 0) bc[0] = atomicAdd(ctr, 1u);
    for (int it = 0;; ++it) {
        __syncthreads();
        const unsigned item = bc[it & 1];
        unsigned nxt = 0u; if (F.tid == 0 && item < 2048u) nxt = atomicAdd(ctr, 1u);
        if (item >= 2048u) break;
        for (int rp = 0; rp < 1 + MIX_REP_PREP; ++rp) pend = gdn_prep_item(F, l, sumsq, (int)((item + (unsigned)rp * MIX_REP_SHIFT_P) & 2047u), qslot, pend);
        if (F.tid == 0) bc[(it + 1) & 1] = nxt;
    }
    if (pend) { VM_WAIT(); __syncthreads(); if (F.tid == 0) __hip_atomic_store(pend, 1u, __ATOMIC_RELAXED, __HIP_MEMORY_SCOPE_AGENT); pend = nullptr; }
    for (int k = 0; k < (ATTN_XCD_QUEUES ? 8 : 1); ++k) { const unsigned q = ATTN_XCD_QUEUES ? (unsigned)((F.bid + k) & 7) : 0u, qn = ATTN_XCD_QUEUES ? 64u : 512u;
        for (;;) {
            __syncthreads(); if (F.tid == 0) bc[0] = atomicAdd(cA + q, 1u); __syncthreads();
            const unsigned j = bc[0]; if (j >= qn) break;
            const unsigned item = (q << 6) | j;
            for (int rp = 0; rp < 1 + MIX_REP_ATTN; ++rp) attn_item(F, (item + (unsigned)rp * MIX_REP_SHIFT_A) & 511u); } }
#ifdef MIX_DENSE_ATTN
    for (int dr = 0; dr < MIX_DENSE_ATTN; ++dr) { unsigned* c2 = ctr + 16 + 8 * dr;
      for (;;) { __syncthreads(); if (F.tid == 0) bc[0] = atomicAdd(c2, 1u); __syncthreads(); const unsigned item = bc[0]; if (item >= 512u) break; attn_item<MIX_DENSE_LO, MIX_DENSE_HI, MIX_DENSE_NOBAR, MIX_DENSE_MODE>(F, item); } }
#endif
}
__device__ __forceinline__ void phase_fixup(Frame& F, int l) {
    const float* hf = (const float*)(F.ws + WS_HFIRST); const float* uf = (const float*)(F.ws + WS_UFIRST); const float* hl = (const float*)(F.ws + WS_HLAST);
    const float* cw = F.ffn_conv + (size_t)l * 3 * DFF; bf16* act = (bf16*)(F.ws + WS_ACT);
    constexpr int NE = 128 * 2 * DFF; const int stride = F.G * NTHREADS;
    for (int i0 = F.bid * NTHREADS + F.tid; i0 < NE; i0 += 6 * stride) {
    float g0[6], g1[6], gm1[6], gm2[6], u0[6], w0[6], w1[6], w2[6];
#pragma unroll
    for (int q = 0; q < 6; ++q) { const int i = i0 + q * stride; const bool ok = i < NE; const int ii = ok ? i : 0;
        const int pm = ii / (2 * DFF), r = (ii / DFF) & 1, c = ii % DFF; const bool halo = (pm % 16) != 0; const int pmm = halo ? pm - 1 : pm;
        g0[q] = hf[((size_t)pm * 2 + 0) * DFF + c]; g1[q] = hf[((size_t)pm * 2 + 1) * DFF + c];
        gm1[q] = hl[((size_t)pmm * 2 + 1) * DFF + c]; gm2[q] = hl[((size_t)pmm * 2 + 0) * DFF + c]; if (!halo) { gm1[q] = 0.f; gm2[q] = 0.f; }
        u0[q] = uf[((size_t)pm * 2 + r) * DFF + c]; w0[q] = cw[c]; w1[q] = cw[DFF + c]; w2[q] = cw[2 * DFF + c]; }
    asm volatile("" ::: "memory");
#pragma unroll
    for (int q = 0; q < 6; ++q) { const int i = i0 + q * stride; if (i < NE) { const int pm = i / (2 * DFF), r = (i / DFF) & 1, c = i % DFF;
        const float cv = (r == 0) ? (w0[q] * gm2[q] + w1[q] * gm1[q] + w2[q] * g0[q]) : (w0[q] * gm1[q] + w1[q] * g0[q] + w2[q] * g1[q]);
        act[(size_t)(pm * 256 + r) * DFF + c] = (bf16)f2bf(silu_acc(cv) * u0[q]); } }
    }
}
__device__ __forceinline__ void fixup_panel(Frame& F, int l, int pm) {
    const float* hf = (const float*)(F.ws + WS_HFIRST); const float* uf = (const float*)(F.ws + WS_UFIRST); const float* hl = (const float*)(F.ws + WS_HLAST);
    const float* cw = F.ffn_conv + (size_t)l * 3 * DFF; bf16* act = (bf16*)(F.ws + WS_ACT);
    const bool halo = (pm % 16) != 0; const int pmm = halo ? pm - 1 : pm;
#pragma unroll 1
    for (int q0 = 0; q0 < 11; q0 += 6) {
        float g0[6], g1[6], gm1[6], gm2[6], u0[6], w0[6], w1[6], w2[6];
#pragma unroll
        for (int q = 0; q < 6; ++q) { const int i = F.tid + (q0 + q < 11 ? q0 + q : 10) * NTHREADS; const int r = i / DFF, c = i % DFF;
            g0[q] = hf[((size_t)pm * 2 + 0) * DFF + c]; g1[q] = hf[((size_t)pm * 2 + 1) * DFF + c];
            gm1[q] = hl[((size_t)pmm * 2 + 1) * DFF + c]; gm2[q] = hl[((size_t)pmm * 2 + 0) * DFF + c]; if (!halo) { gm1[q] = 0.f; gm2[q] = 0.f; }
            u0[q] = uf[((size_t)pm * 2 + r) * DFF + c]; w0[q] = cw[c]; w1[q] = cw[DFF + c]; w2[q] = cw[2 * DFF + c]; }
        asm volatile("" ::: "memory");
#pragma unroll
        for (int q = 0; q < 6; ++q) if (q0 + q < 11) { const int i = F.tid + (q0 + q) * NTHREADS; const int r = i / DFF, c = i % DFF;
            const float cv = (r == 0) ? (w0[q] * gm2[q] + w1[q] * gm1[q] + w2[q] * g0[q]) : (w0[q] * gm1[q] + w1[q] * g0[q] + w2[q] * g1[q]);
            act[(size_t)(pm * 256 + r) * DFF + c] = (bf16)f2bf(silu_acc(cv) * u0[q]); }
    }
}
static_assert(11 * NTHREADS == 2 * DFF, "fixup_panel covers 2 x DFF elements with 11 per thread");
__device__ __forceinline__ void phase_final(Frame& F, const pg8::ssq_t* sumsq) {
    const int gw = F.bid * NWAVES + F.wave, NGW = F.G * NWAVES;
    const f32x4* g4 = (const f32x4*)F.ln_f + F.lane;
    f32x4 g[4];
#pragma unroll
    for (int j = 0; j < 4; ++j) g[j] = g4[64 * j];
    for (int m0 = gw * 4; m0 < T; m0 += NGW * 4) {
        uint2 v[4][4]; float rs[4];
#pragma unroll
        for (int r = 0; r < 4; ++r) { const uint2* xr = (const uint2*)((const bf16*)(F.ws + WS_XB) + (size_t)(m0 + r) * DM) + F.lane; rs[r] = __builtin_amdgcn_rsqf(pg8::ssq_val(sumsq[m0 + r]) * (1.0f / 1024.0f) + 1e-6f);
#pragma unroll
            for (int j = 0; j < 4; ++j) v[r][j] = xr[64 * j]; }
#pragma unroll
        for (int r = 0; r < 4; ++r) { f32x4* xr = (f32x4*)(F.out + (size_t)(m0 + r) * DM) + F.lane;
#pragma unroll
            for (int j = 0; j < 4; ++j) { const uint2 q = v[r][j];
                const f32x4 x4 = {__builtin_bit_cast(float, q.x << 16), __builtin_bit_cast(float, q.x & 0xffff0000u), __builtin_bit_cast(float, q.y << 16), __builtin_bit_cast(float, q.y & 0xffff0000u)};
                xr[64 * j] = x4 * rs[r] * g[j]; } }
    }
}

__global__ void __launch_bounds__(NTHREADS, 2) mk_fwd(Args args) {
    extern __shared__ __attribute__((aligned(16))) unsigned char lds[];
    Frame F;
    F.lds = (LAS unsigned char*)lds;
    const int wave0 = __builtin_amdgcn_readfirstlane(threadIdx.x >> 6);
    F.tid = threadIdx.x; F.lane = F.tid & 63; F.wave = wave0; F.G = gridDim.x; F.bid = blockIdx.x;
    F.x = args.in[0]; F.ln1 = args.in[1]; F.w_in = args.in[2]; F.conv_qkv = args.in[3]; F.a_log = args.in[4]; F.dt_bias = args.in[5]; F.gdn_norm = args.in[6];
    F.w_out = args.in[7]; F.ln2 = args.in[8]; F.w_gate = args.in[9]; F.w_up = args.in[10]; F.ffn_conv = args.in[11]; F.w_down = args.in[12]; F.ln_f = args.in[13];
    F.out = args.out; F.ws = args.ws;
    volatile LAS unsigned* MISC = (volatile LAS unsigned*)(F.lds + MISC_OFF);
    for (int u = F.tid; u < (LDS_BYTES - LDSCTL_OFF) / 4; u += NTHREADS) ((LAS unsigned*)(F.lds + LDSCTL_OFF))[u] = 0u;
    __syncthreads();
    unsigned* ctl = (unsigned*)(F.ws + WS_CTL);
#if !MK_SPLIT
    XcdBarrier bar = xcd_barrier_post(ctl + CW_BAR, MISC + 8);
#endif
    const int lo = args.ph_lo, hi = args.ph_hi;
    pg8::ssq_t* sumsq = (pg8::ssq_t*)(F.ws + WS_SUMSQ);
    int seam = 0;
#if MK_SPLIT
#define SEAM() do { } while (0)
#else
#ifndef SEAM_REP
#define SEAM_REP 0
#endif
#ifndef SEAM_CG
#define SEAM_CG 0
#endif
#define SEAM() do { if (SEAM_CG && seam == 0) { cg::this_grid().sync(); } else { xcd_barrier(bar); for (int sr_ = 0; sr_ < SEAM_REP; ++sr_) xcd_barrier(bar); } ++seam; } while (0)
#endif
#define REFRESH() do { int ln_ = (int)__builtin_amdgcn_mbcnt_hi(~0u, __builtin_amdgcn_mbcnt_lo(~0u, 0u)); asm volatile("" : "+v"(ln_)); int w_ = wave0; asm volatile("" : "+s"(w_)); F.lane = ln_; F.wave = w_; F.tid = w_ * 64 + ln_; } while (0)
#define IN(k) (lo <= (k) && (k) < hi)
#define BOTH(k) (IN(k) && IN((k) + 1))
#ifndef PH_MASK
#define PH_MASK 0xff
#endif
#ifndef ALIGN_PLAIN
#define ALIGN_PLAIN true
#endif
#ifndef REP_PHASE
#define REP_PHASE -1
#endif
#ifndef REP_N
#define REP_N 0
#endif
#define NREP(id) (1 + ((REP_PHASE) == (id) ? (REP_N) : 0))
    if ((PH_MASK & 1) && IN(0)) { for (int rep = 0; rep < NREP(0); ++rep) { REFRESH(); phase_p0(F); }

#if !MK_SPLIT
        __syncthreads(); xcd_census(bar);
#endif
        if (BOTH(0)) SEAM(); }
    for (int l = 0; l < DEPTH; ++l) {
        const int pb = 1 + 6 * l;
        const pg8::ssq_t* ss1 = sumsq + (size_t)(2 * l) * T;
        pg8::ssq_t* ss2 = sumsq + (size_t)(2 * l + 1) * T;
        pg8::ssq_t* ss3 = sumsq + (size_t)(2 * l + 2) * T;
        if ((PH_MASK & 2) && IN(pb + 0)) {
            REFRESH();
            pg8::Gemm g{(const bf16*)(F.ws + WS_XB), (const bf16*)(F.ws + WS_WIN) + (size_t)l * NIN * DM, T, NIN, DM}; pg8::StaticOrder S; S.init(T, NIN, F.G, F.bid);
            pg8::EpiProj E{(bf16*)(F.ws + WS_PA), 1536, (bf16*)(F.ws + WS_PREST), 2048, 6, ss1, F.gdn_norm + l * 128, (const PG8_LAS float*)(F.lds + pg8::SIDE_OFF),
                            F.conv_qkv + (size_t)l * 4 * 1536, (float*)(F.ws + WS_QFIRST), (float*)(F.ws + WS_QLAST), (PG8_LAS pg8::f32x4*)(F.lds + XL_OFF), 0};
#ifdef PROBE_NULL_REP
            for (int rep = 0; rep < NREP(1); ++rep) { E.skip = (rep + 1 < NREP(1)); pg8::gemm_phase<pg8::EpiProj, pg8::StaticOrder, ALIGN_PLAIN, PG8_SP2>(F.lds + RING_OFF, g, S, E, F.tid); }
#else
            for (int rep = 0; rep < NREP(1); ++rep) pg8::gemm_phase<pg8::EpiProj, pg8::StaticOrder, ALIGN_PLAIN, PG8_SP2>(F.lds + RING_OFF, g, S, E, F.tid);
#endif
#ifdef PROBE_NULL_GEMM
            for (int rep = 0; rep < PROBE_NULL_GEMM; ++rep) { pg8::EpiNull En; pg8::gemm_phase<pg8::EpiNull, pg8::StaticOrder, true, PG8_SP2>(F.lds + RING_OFF, g, S, En, F.tid); }
#endif
            REFRESH(); logits_phase(F, l, ss1);
            if (BOTH(pb + 0)) SEAM();
        }
        if ((PH_MASK & 8) && IN(pb + 1)) { for (int rep = 0; rep < NREP(3); ++rep) { REFRESH(); phase_mixer(F, l, ss1, l + 2 * rep); } if (BOTH(pb + 1)) SEAM(); }
        if ((PH_MASK & 16) && IN(pb + 2)) {
            REFRESH();
            pg8::Gemm g{(const bf16*)(Y_BASE(F)), (const bf16*)(F.ws + WS_WOUT) + (size_t)l * DM * DM, T, DM, DM}; pg8::StaticOrder S; S.init(T, DM, F.G, F.bid);
            pg8::EpiResid E{(bf16*)(F.ws + WS_XB), ss2};
            pg8::gemm_phase<pg8::EpiResid, pg8::StaticOrder, ALIGN_PLAIN, PG8_SP2>(F.lds + RING_OFF, g, S, E, F.tid);
            if (BOTH(pb + 2)) SEAM();
        }
        if ((PH_MASK & 32) && IN(pb + 3)) {
            REFRESH();
            pg8::Gemm g{(const bf16*)(F.ws + WS_XB), (const bf16*)(F.ws + WS_WGU) + (size_t)l * NGU * DM, T, NGU, DM}; pg8::StaticOrder S; S.init(T, NGU, F.G, F.bid);
            pg8::EpiGateUp E{(bf16*)(F.ws + WS_ACT), ss2, F.ffn_conv + (size_t)l * 3 * DFF, (float*)(F.ws + WS_HFIRST), (float*)(F.ws + WS_UFIRST), (float*)(F.ws + WS_HLAST), (PG8_LAS pg8::f32x4*)(F.lds + XL_OFF), (const PG8_LAS float*)(F.lds + pg8::SIDE_OFF)};
            for (int rep = 0; rep < NREP(5); ++rep) pg8::gemm_phase<pg8::EpiGateUp, pg8::StaticOrder, true, PG8_SP2>(F.lds + RING_OFF, g, S, E, F.tid);
            if (BOTH(pb + 3)) SEAM();
        }
#ifndef MERGE_FIXUP
#define MERGE_FIXUP 1
#endif
        if (!MERGE_FIXUP && (PH_MASK & 64) && IN(pb + 4)) { REFRESH(); phase_fixup(F, l); if (BOTH(pb + 4)) SEAM(); }
        if ((PH_MASK & 128) && IN(pb + 5)) {
            REFRESH();
            pg8::Gemm g{(const bf16*)(F.ws + WS_ACT), (const bf16*)(F.ws + WS_WD) + (size_t)l * DM * DFF, T, DM, DFF}; pg8::StaticOrder S; S.init(T, DM, F.G, F.bid);
            if (MERGE_FIXUP) { pg8::Unit fu; int lastpm = -1; for (int ui = 0; S.next(ui, fu); ++ui) if (fu.pm != lastpm) { fixup_panel(F, l, fu.pm); lastpm = fu.pm; } VM_WAIT(); __syncthreads(); }
            pg8::EpiResid E{(bf16*)(F.ws + WS_XB), ss3};
            pg8::gemm_phase<pg8::EpiResid, pg8::StaticOrder, ALIGN_PLAIN, PG8_SP2>(F.lds + RING_OFF, g, S, E, F.tid);
            if (BOTH(pb + 5)) SEAM();
        }
    }
    if (IN(NPHASE - 1)) { REFRESH(); } if (IN(NPHASE - 1)) phase_final(F, sumsq + (size_t)(2 * DEPTH) * T);
#undef IN
#undef BOTH
#undef SEAM
}

extern "C" void kernel_launch(void* const* d_in, const int* in_sizes, int n_in, void* d_out, int out_size, void* d_ws, size_t ws_size, hipStream_t stream) {
    static int grid = 0;
    if (grid == 0) {
        if (n_in != 14 || in_sizes[0] != T * DM || out_size != T * DM || ws_size < WS_END) { fprintf(stderr, "kernel_launch: unexpected shapes (n_in %d, in0 %d, out %d, ws %zu < %zu)\n", n_in, n_in > 0 ? in_sizes[0] : -1, out_size, ws_size, (size_t)WS_END); grid = -1; return; }
        int dev = 0, cus = 0, per_cu = 0;
        if (hipGetDevice(&dev) != hipSuccess || hipDeviceGetAttribute(&cus, hipDeviceAttributeMultiprocessorCount, dev) != hipSuccess) { grid = -1; return; }
        if (hipFuncSetAttribute((const void*)mk_fwd, hipFuncAttributeMaxDynamicSharedMemorySize, LDS_BYTES) != hipSuccess) { fprintf(stderr, "kernel_launch: hipFuncSetAttribute failed\n"); grid = -1; return; }
        if (hipOccupancyMaxActiveBlocksPerMultiprocessor(&per_cu, (const void*)mk_fwd, NTHREADS, LDS_BYTES) != hipSuccess || per_cu < 1) { fprintf(stderr, "kernel_launch: occupancy query says %d blocks per CU\n", per_cu); (void)hipGetLastError(); grid = -1; return; }
        grid = cus;
        if ((T * 12) % (grid * 4) != 0) { fprintf(stderr, "kernel_launch: grid %d does not divide the naive prep items\n", grid); grid = -1; return; }
    }
    if (grid < 0) return;
    if (hipMemsetAsync((char*)d_ws + WS_CTL, 0, CTL_ZERO_BYTES, stream) != hipSuccess) { fprintf(stderr, "kernel_launch: memset failed\n"); return; }
    Args a{};
    for (int i = 0; i < 14; ++i) a.in[i] = (const float*)d_in[i];
    a.out = (float*)d_out; a.ws = (unsigned char*)d_ws;
#if MK_SPLIT
    for (int ph = 0; ph < NPHASE; ++ph) { a.ph_lo = ph; a.ph_hi = ph + 1; hipLaunchKernelGGL(mk_fwd, dim3(grid), dim3(NTHREADS), LDS_BYTES, stream, a); }
#else
    a.ph_lo = 0; a.ph_hi = NPHASE;
    void* kargs[] = {&a};
    hipError_t e = hipLaunchCooperativeKernel((const void*)mk_fwd, dim3(grid), dim3(NTHREADS), kargs, LDS_BYTES, stream);
    if (e != hipSuccess) fprintf(stderr, "kernel_launch: cooperative launch failed: %s (grid %d)\n", hipGetErrorString(e), grid);
#endif
}
```

```cpp
#include <hip/hip_runtime.h>
#include <hip/hip_cooperative_groups.h>
#include <cstdio>
#include <cstdint>
namespace cg = cooperative_groups;

namespace pg8 {
#define PG8_LAS __attribute__((address_space(3)))
typedef unsigned short bf16_t;
typedef short bf16x8 __attribute__((ext_vector_type(8)));
typedef float f32x4 __attribute__((ext_vector_type(4)));
typedef unsigned u32x4 __attribute__((ext_vector_type(4)));
constexpr int BM = 256, BK = 64, HALF = 128, HTB = HALF * BK * 2  , STAGE_BYTES = 8 * HTB, NXCD = 8;
#ifndef PG8_WGM
#define PG8_WGM 8
#endif
constexpr int WGM = PG8_WGM;

__host__ __device__ __forceinline__ int lds_byte(int r, int c) { const int st = (r >> 4) * 2 + (c >> 5), rr = r & 15, cc = c & 31, ob = rr * 64 + cc * 2; return st * 1024 + (ob ^ (((ob >> 9) & 1) << 5)); }
__host__ __device__ __forceinline__ void stage_rc(int b, int& R, int& C) { const int st = b / 1024, sb = b % 1024, swz = sb ^ (((sb >> 9) & 1) << 5); R = (st >> 1) * 16 + swz / 64; C = (st & 1) * 32 + (swz % 64) / 2; }
__host__ __device__ __forceinline__ int perm32(int rho) { const int n = rho >> 4, i = rho & 15; return 8 * (i >> 2) + 4 * n + (i & 3); }

typedef unsigned long long ssq_t;
__device__ __forceinline__ ssq_t ssq_pack(float s) { return (ssq_t)(s * 1048576.0f); }
__device__ __forceinline__ float ssq_val(ssq_t q) { return (float)(unsigned)(q >> 20) + (float)((unsigned)q & 0xfffffu) * (1.0f / 1048576.0f); }
struct Unit { int pm, pn; };
struct Gemm { const bf16_t* A; const bf16_t* Bt; int M, N, K; };

struct StaticOrder {
    int nM, nN, nwg, G, c;
    __host__ __device__ void init(int M, int N, int G_, int c_) { nM = M / BM; nN = N / BM; nwg = nM * nN; G = G_; c = c_; }
    __host__ __device__ bool next(int i, Unit& u) const {
        const long L = (long)i * G + c; if (L >= nwg) return false;
        int wgid = (int)L; { const int q = nwg / NXCD, r = nwg % NXCD, xcd = wgid % NXCD, off = wgid / NXCD; wgid = (xcd < r ? xcd * (q + 1) : r * (q + 1) + (xcd - r) * q) + off; }
        const int nig = WGM * nN, gid = wgid / nig, fm = gid * WGM, gsz = (nM - fm) < WGM ? (nM - fm) : WGM;
        u.pm = fm + ((wgid % nig) % gsz); u.pn = (wgid % nig) / gsz; return true;
    }
    __device__ __forceinline__ void a_ready(const Unit&) const {}
    __device__ __forceinline__ void done(const Unit&) const {}
};


typedef __bf16 bf16v2_t __attribute__((ext_vector_type(2)));
typedef float f32v2_t __attribute__((ext_vector_type(2)));
__device__ __forceinline__ unsigned cvt_pk_bf16(float lo, float hi) { const f32v2_t v = {lo, hi}; return __builtin_bit_cast(unsigned, __builtin_convertvector(v, bf16v2_t)); }
typedef unsigned u32x2 __attribute__((ext_vector_type(2)));
constexpr float RMS_EPS = 1e-6f;
constexpr int SIDE_OFF = 143360, SIDE_BYTES = 8192, SIDE_SSQ = 6144  ;

__device__ __forceinline__ float dpp_ror1(float v) { return __builtin_bit_cast(float, __builtin_amdgcn_update_dpp(0, __builtin_bit_cast(int, v), 0x121, 0xf, 0xf, false)); }
__device__ __forceinline__ float dpp_ror2(float v) { return __builtin_bit_cast(float, __builtin_amdgcn_update_dpp(0, __builtin_bit_cast(int, v), 0x122, 0xf, 0xf, false)); }
__device__ __forceinline__ f32x4 ror1v(f32x4 v) { return (f32x4){dpp_ror1(v[0]), dpp_ror1(v[1]), dpp_ror1(v[2]), dpp_ror1(v[3])}; }
__device__ __forceinline__ f32x4 ror2v(f32x4 v) { return (f32x4){dpp_ror2(v[0]), dpp_ror2(v[1]), dpp_ror2(v[2]), dpp_ror2(v[3])}; }
__device__ __forceinline__ float dpp_ror3(float v) { return __builtin_bit_cast(float, __builtin_amdgcn_update_dpp(0, __builtin_bit_cast(int, v), 0x123, 0xf, 0xf, false)); }
__device__ __forceinline__ f32x4 ror3v(f32x4 v) { return (f32x4){dpp_ror3(v[0]), dpp_ror3(v[1]), dpp_ror3(v[2]), dpp_ror3(v[3])}; }
template <int K> __device__ __forceinline__ float dpp_prev(float g, float gp) {
    const int o = __builtin_amdgcn_update_dpp(0, __builtin_bit_cast(int, gp), 0x120 + K, 0xf, 0xf, false);
    return __builtin_bit_cast(float, __builtin_amdgcn_update_dpp(o, __builtin_bit_cast(int, g), 0x110 + K, 0xf, 0xf, false));
}
template <int K> __device__ __forceinline__ f32x4 prevv(f32x4 g, f32x4 gp) { return (f32x4){dpp_prev<K>(g[0], gp[0]), dpp_prev<K>(g[1], gp[1]), dpp_prev<K>(g[2], gp[2]), dpp_prev<K>(g[3], gp[3])}; }
#ifndef EPI_WT
#define EPI_WT 0
#endif
#ifndef EPI_NT
#define EPI_NT 0
#endif
template <int BIT> __device__ __forceinline__ void st16(void* p, u32x4 v) {
    if constexpr ((EPI_WT & BIT) != 0) asm volatile("global_store_dwordx4 %0, %1, off sc1\n\ts_nop 1" :: "v"(p), "v"(v) : "memory");
    else if constexpr ((EPI_NT & BIT) != 0) __builtin_nontemporal_store(v, (u32x4*)p);
    else *(u32x4*)p = v;
}
__device__ __forceinline__ float dpp_shr1(float g, float old) { return __builtin_bit_cast(float, __builtin_amdgcn_update_dpp(__builtin_bit_cast(int, old), __builtin_bit_cast(int, g), 0x111, 0xf, 0xf, false)); }
__device__ __forceinline__ f32x4 shr1v(f32x4 g, f32x4 o) { return (f32x4){dpp_shr1(g[0], o[0]), dpp_shr1(g[1], o[1]), dpp_shr1(g[2], o[2]), dpp_shr1(g[3], o[3])}; }
__device__ __forceinline__ float silu_f(float v) { return v * __builtin_amdgcn_rcpf(1.0f + __builtin_amdgcn_exp2f(-1.44269504089f * v)); }
struct EpiProj {
    static constexpr bool PERM = true, APERM = true, AFTER_DRAIN = false, IDEMPOTENT = false, TWICE = true;
#ifdef PROBE_EPI_TWICE
    __device__ __forceinline__ bool twice(const Unit& u) const { return (PROBE_EPI_TWICE == 1) ? (u.pn < split_pn) : (PROBE_EPI_TWICE == 2) ? (u.pn >= split_pn) : (PROBE_EPI_TWICE == 5) ? (u.pn >= split_pn + 2) : false; }
#endif
    bf16_t* O0; int ld0; bf16_t* O1  ; bf16_t* QKV  ; int split_pn; const ssq_t* sumsq; const float* zgain; const PG8_LAS float* sidef;
    const float* cw  ; float* qfirst; float* qlast  ; PG8_LAS f32x4* xl  ;
    int skip;
    unsigned char* pscr;
    __device__ __forceinline__ void side(const Unit& u, PG8_LAS unsigned char* lds, int par, int wid, int lane_in) const {
        int lane = lane_in; asm volatile("" : "+v"(lane));
        if (wid == 0 || wid == 7) __builtin_amdgcn_global_load_lds((const unsigned*)(sumsq + u.pm * BM + (wid ? 128 : 0) + 2 * lane), (PG8_LAS unsigned*)(lds + SIDE_OFF + par * SIDE_BYTES + SIDE_SSQ + (wid ? 1024 : 0)), 16, 0, 0);
        if (wid == 1) __builtin_amdgcn_global_load_lds((const unsigned*)(zgain + 4 * (lane & 31)), (PG8_LAS unsigned*)(lds + SIDE_OFF + par * SIDE_BYTES + 1024), 16, 0, 0);
        if (wid >= 2 && wid < 6 && u.pn < split_pn) __builtin_amdgcn_global_load_lds((const unsigned*)(cw + (wid - 2) * 1536 + u.pn * BM + 4 * lane), (PG8_LAS unsigned*)(lds + SIDE_OFF + par * SIDE_BYTES + 2048 + (wid - 2) * 1024), 16, 0, 0);
    }
    __device__ __forceinline__ void operator()(f32x4 (&acc)[2][2][4][2], const Unit& u, int wr, int wc, int fr, int fq, int par, bool unit_scale = false) const {
        if (skip) {
#pragma unroll
            for (int ai = 0; ai < 2; ++ai)
#pragma unroll
                for (int bj = 0; bj < 2; ++bj)
#pragma unroll
                    for (int m = 0; m < 4; ++m) asm volatile("" :: "v"(acc[ai][bj][m][0]), "v"(acc[ai][bj][m][1]));
            return; }
        const int rloc = wr * 64 + 4 * fr, row0 = u.pm * BM + rloc; const PG8_LAS float* sf = sidef + par * (SIDE_BYTES / 4);
#pragma unroll
        for (int ai = 0; ai < 2; ++ai) { const PG8_LAS ssq_t* sp = (const PG8_LAS ssq_t*)((const PG8_LAS unsigned char*)sf + SIDE_SSQ) + ai * HALF + rloc;
#pragma unroll
            for (int m = 0; m < 4; ++m) { float rs = __builtin_amdgcn_rsqf(ssq_val(sp[m]) * (1.0f / 1024.0f) + RMS_EPS); if (unit_scale) rs = 1.0f;
#pragma unroll
                for (int bj = 0; bj < 2; ++bj)
#pragma unroll
                    for (int n = 0; n < 2; ++n) acc[ai][bj][m][n] = acc[ai][bj][m][n] * rs; } }
        if (u.pn < split_pn) {
            const int wid = wr * 4 + wc, colt = u.pn * BM + wc * 32 + 8 * fq;
            if (fr == 15) {
#pragma unroll
                for (int ai = 0; ai < 2; ++ai) if (wr == 0 || ai == 0) {
#pragma unroll
                    for (int bj = 0; bj < 2; ++bj)
#pragma unroll
                        for (int n = 0; n < 2; ++n)
#pragma unroll
                            for (int jj = 0; jj < 3; ++jj) xl[wid * 96 + (((ai * 2 + bj) * 2 + n) * 4 + fq) * 3 + jj] = acc[ai][bj][jj + 1][n]; } }
            if (wr == 0 && fr == 0) {
#pragma unroll
                for (int bj = 0; bj < 2; ++bj)
#pragma unroll
                    for (int n = 0; n < 2; ++n)
#pragma unroll
                        for (int m = 0; m < 3; ++m) *(f32x4*)(qfirst + ((size_t)u.pm * 3 + m) * 1536 + colt + bj * HALF + 4 * n) = acc[0][bj][m][n]; }
            if (wr == 1 && fr == 15) {
#pragma unroll
                for (int bj = 0; bj < 2; ++bj)
#pragma unroll
                    for (int n = 0; n < 2; ++n)
#pragma unroll
                        for (int jj = 0; jj < 3; ++jj) *(f32x4*)(qlast + ((size_t)u.pm * 3 + jj) * 1536 + colt + bj * HALF + 4 * n) = acc[1][bj][jj + 1][n]; }
            asm volatile("s_waitcnt lgkmcnt(0)" ::: "memory"); __builtin_amdgcn_s_barrier(); asm volatile("" ::: "memory");
            const int swid = (wr == 1) ? wc : (4 + wc);
#pragma unroll
            for (int bj = 0; bj < 2; ++bj) { const int cl = bj * HALF + wc * 32 + 8 * fq;
                f32x4 w0[2], w1[2], w2[2], w3[2];
#pragma unroll
                for (int n = 0; n < 2; ++n) { w0[n] = *(const PG8_LAS f32x4*)(sf + 512 + cl + 4 * n); w1[n] = *(const PG8_LAS f32x4*)(sf + 768 + cl + 4 * n); w2[n] = *(const PG8_LAS f32x4*)(sf + 1024 + cl + 4 * n); w3[n] = *(const PG8_LAS f32x4*)(sf + 1280 + cl + 4 * n); }
#pragma unroll
                for (int ai = 0; ai < 2; ++ai) { const int sai = (wr == 1) ? ai : 0; u32x4 w[4];
#pragma unroll
                    for (int n = 0; n < 2; ++n) { f32x4 pv[3];
#pragma unroll
                        for (int jj = 0; jj < 3; ++jj) { pv[jj] = (f32x4){0.f, 0.f, 0.f, 0.f}; if (fr == 0 && (wr == 1 || ai == 1)) pv[jj] = xl[swid * 96 + (((sai * 2 + bj) * 2 + n) * 4 + fq) * 3 + jj]; }
                        const f32x4 g0 = acc[ai][bj][0][n], g1 = acc[ai][bj][1][n], g2 = acc[ai][bj][2][n], g3 = acc[ai][bj][3][n];
                        const f32x4 P1 = shr1v(g1, pv[0]), P2 = shr1v(g2, pv[1]), P3 = shr1v(g3, pv[2]);
                        f32x4 o[4];
                        o[0] = w0[n] * P1 + w1[n] * P2 + w2[n] * P3 + w3[n] * g0; o[1] = w0[n] * P2 + w1[n] * P3 + w2[n] * g0 + w3[n] * g1;
                        o[2] = w0[n] * P3 + w1[n] * g0 + w2[n] * g1 + w3[n] * g2; o[3] = w0[n] * g0 + w1[n] * g1 + w2[n] * g2 + w3[n] * g3;
#pragma unroll
                        for (int m = 0; m < 4; ++m) { const unsigned a = cvt_pk_bf16(silu_f(o[m][0]), silu_f(o[m][1])), b = cvt_pk_bf16(silu_f(o[m][2]), silu_f(o[m][3]));
                            if (n == 0) { w[m].x = a; w[m].y = b; } else { w[m].z = a; w[m].w = b; } } }
#pragma unroll
                    for (int m = 0; m < 4; ++m) { const int row = row0 + ai * HALF + m, c = colt + bj * HALF;
                        st16<1>(O0 + ((size_t)(((row >> 12) * 4 + ((c >> 7) & 3)) * 4096 + (row & 4095))) * 384 + ((c >> 9) * 128 + (c & 127)), w[m]); }
                } }
            return;
        }
        const int col0 = (u.pn - split_pn) * BM + wc * 32 + 8 * fq;
        const bool zt = (u.pn == split_pn) || (u.pn == split_pn + 1);
        f32x4 zg[2][2];
#pragma unroll
        for (int bj = 0; bj < 2; ++bj)
#pragma unroll
            for (int n = 0; n < 2; ++n) zg[bj][n] = *(const PG8_LAS f32x4*)(sf + 256 + ((col0 + bj * HALF + 4 * n) & 127));
#pragma unroll
        for (int ai = 0; ai < 2; ++ai)
#pragma unroll
            for (int m = 0; m < 4; ++m) { const int row = row0 + ai * HALF + m;
#pragma unroll
                for (int bj = 0; bj < 2; ++bj) { f32x4 v0 = acc[ai][bj][m][0], v1 = acc[ai][bj][m][1];
                    const int c = col0 + bj * HALF, cp = c - 512;
                    bf16_t* rowp = zt ? O1 + (size_t)row * 512 + c
                                      : QKV + ((size_t)(((row >> 12) * 8 + ((cp >> 6) & 7)) * 4096 + (row & 4095))) * 192 + ((cp >> 9) * 64 + (cp & 63));
                    if (zt) { v0 = (f32x4){silu_f(v0[0]), silu_f(v0[1]), silu_f(v0[2]), silu_f(v0[3])} * zg[bj][0]; v1 = (f32x4){silu_f(v1[0]), silu_f(v1[1]), silu_f(v1[2]), silu_f(v1[3])} * zg[bj][1]; }
                    u32x4 w; w.x = cvt_pk_bf16(v0[0], v0[1]); w.y = cvt_pk_bf16(v0[2], v0[3]); w.z = cvt_pk_bf16(v1[0], v1[1]); w.w = cvt_pk_bf16(v1[2], v1[3]);
#ifdef PROBE_STORE_PATTERN
                    if (unit_scale) { *(u32x4*)(pscr + ((size_t)(((u.pm * 14 + u.pn) & 255) * 8 + (wr * 4 + wc)) * 16 + ((ai * 4 + m) * 2 + bj)) * 1024 + (fq * 16 + fr) * 16) = w; continue; }
#endif
                    st16<1>(rowp, w); } }
    }
};
struct EpiNull {
    static constexpr bool PERM = true, APERM = false, AFTER_DRAIN = false, IDEMPOTENT = true, TWICE = false;
    __device__ __forceinline__ void side(const Unit&, PG8_LAS unsigned char*, int, int, int) const {}
    __device__ __forceinline__ void operator()(f32x4 (&acc)[2][2][4][2], const Unit&, int, int, int, int, int) const {
#pragma unroll
        for (int ai = 0; ai < 2; ++ai)
#pragma unroll
            for (int bj = 0; bj < 2; ++bj)
#pragma unroll
                for (int m = 0; m < 4; ++m) { asm volatile("" :: "v"(acc[ai][bj][m][0]), "v"(acc[ai][bj][m][1])); }
    }
};
struct EpiResid {
    static constexpr bool PERM = true, APERM = false, AFTER_DRAIN = false, IDEMPOTENT = false, TWICE = false;
    bf16_t* xb; ssq_t* sumsq;
    __device__ __forceinline__ void side(const Unit&, PG8_LAS unsigned char*, int, int, int) const {}
    __device__ __forceinline__ void operator()(f32x4 (&acc)[2][2][4][2], const Unit& u, int wr, int wc, int fr, int fq, int par) const {
        const int row0 = u.pm * BM + wr * 64 + fr, col0 = u.pn * BM + wc * 32 + 8 * fq;
#pragma unroll
        for (int ai = 0; ai < 2; ++ai) {
            u32x4 r[4][2];
#pragma unroll
            for (int m = 0; m < 4; ++m)
#pragma unroll
                for (int bj = 0; bj < 2; ++bj) r[m][bj] = *(const u32x4*)(xb + (size_t)(row0 + ai * HALF + m * 16) * 1024 + col0 + bj * HALF);
            asm volatile("" ::: "memory");
#pragma unroll
            for (int m = 0; m < 4; ++m) { const int row = row0 + ai * HALF + m * 16; float ss = 0.f;
#pragma unroll
                for (int bj = 0; bj < 2; ++bj) { const u32x4 q = r[m][bj];
                    const f32x4 o0 = (f32x4){__builtin_bit_cast(float, q.x << 16), __builtin_bit_cast(float, q.x & 0xffff0000u), __builtin_bit_cast(float, q.y << 16), __builtin_bit_cast(float, q.y & 0xffff0000u)} + acc[ai][bj][m][0];
                    const f32x4 o1 = (f32x4){__builtin_bit_cast(float, q.z << 16), __builtin_bit_cast(float, q.z & 0xffff0000u), __builtin_bit_cast(float, q.w << 16), __builtin_bit_cast(float, q.w & 0xffff0000u)} + acc[ai][bj][m][1];
                    ss += ((o0[0] * o0[0] + o0[1] * o0[1]) + (o0[2] * o0[2] + o0[3] * o0[3])) + ((o1[0] * o1[0] + o1[1] * o1[1]) + (o1[2] * o1[2] + o1[3] * o1[3]));
                    u32x4 w; w.x = cvt_pk_bf16(o0[0], o0[1]); w.y = cvt_pk_bf16(o0[2], o0[3]); w.z = cvt_pk_bf16(o1[0], o1[1]); w.w = cvt_pk_bf16(o1[2], o1[3]);
                    st16<4>(xb + (size_t)row * 1024 + col0 + bj * HALF, w); }
                ss += __shfl_xor(ss, 16); ss += __shfl_xor(ss, 32);
                if (fq == 0) atomicAdd(sumsq + row, ssq_pack(ss)); }
        }
    }
};
struct EpiGateUp {
    static constexpr bool PERM = true, APERM = true, AFTER_DRAIN = false, IDEMPOTENT = false, TWICE = true;
#ifdef PROBE_EPI_TWICE
    __device__ __forceinline__ bool twice(const Unit& u) const { return PROBE_EPI_TWICE == 3; }
#endif
    bf16_t* act; const ssq_t* sumsq; const float* cw  ; float* hfirst; float* ufirst; float* hlast; PG8_LAS f32x4* xl  ; const PG8_LAS float* sidef;
    __device__ __forceinline__ void side(const Unit& u, PG8_LAS unsigned char* lds, int par, int wid, int lane_in) const {
        int lane = lane_in; asm volatile("" : "+v"(lane));
        if (wid == 0 || wid == 7) __builtin_amdgcn_global_load_lds((const unsigned*)(sumsq + u.pm * BM + (wid ? 128 : 0) + 2 * lane), (PG8_LAS unsigned*)(lds + SIDE_OFF + par * SIDE_BYTES + SIDE_SSQ + (wid ? 1024 : 0)), 16, 0, 0);
        if (wid == 1) __builtin_amdgcn_global_load_lds((const unsigned*)(cw + (lane >> 5) * 2816 + u.pn * 128 + 4 * (lane & 31)), (PG8_LAS unsigned*)(lds + SIDE_OFF + par * SIDE_BYTES + 1024), 16, 0, 0);
        if (wid == 2) __builtin_amdgcn_global_load_lds((const unsigned*)(cw + 2 * 2816 + u.pn * 128 + 4 * (lane & 31)), (PG8_LAS unsigned*)(lds + SIDE_OFF + par * SIDE_BYTES + 2048), 16, 0, 0);
    }
    __device__ __forceinline__ void operator()(f32x4 (&acc)[2][2][4][2], const Unit& u, int wr, int wc, int fr, int fq, int par, bool unit_scale = false) const {
        const int rloc = wr * 64 + 4 * fr, row0 = u.pm * BM + rloc, colf = u.pn * 128 + wc * 32 + 8 * fq;
        const int wid = wr * 4 + wc; const PG8_LAS float* sf = sidef + par * (SIDE_BYTES / 4);
#pragma unroll
        for (int ai = 0; ai < 2; ++ai) { const PG8_LAS ssq_t* sp = (const PG8_LAS ssq_t*)((const PG8_LAS unsigned char*)sf + SIDE_SSQ) + ai * HALF + rloc;
#pragma unroll
            for (int m = 0; m < 4; ++m) { float rs = __builtin_amdgcn_rsqf(ssq_val(sp[m]) * (1.0f / 1024.0f) + RMS_EPS); if (unit_scale) rs = 1.0f;
#pragma unroll
                for (int bj = 0; bj < 2; ++bj)
#pragma unroll
                    for (int n = 0; n < 2; ++n) acc[ai][bj][m][n] = acc[ai][bj][m][n] * rs; } }
        if (fr == 15) {
#pragma unroll
            for (int ai = 0; ai < 2; ++ai) if (wr == 0 || ai == 0) {
#pragma unroll
                for (int n = 0; n < 2; ++n)
#pragma unroll
                    for (int jj = 0; jj < 2; ++jj) xl[wid * 64 + ((ai * 2 + n) * 4 + fq) * 2 + jj] = acc[ai][0][jj + 2][n]; }
        }
        if (wr == 0 && fr == 0) {
#pragma unroll
            for (int n = 0; n < 2; ++n)
#pragma unroll
                for (int m = 0; m < 2; ++m) { *(f32x4*)(hfirst + ((size_t)u.pm * 2 + m) * 2816 + colf + 4 * n) = acc[0][0][m][n]; *(f32x4*)(ufirst + ((size_t)u.pm * 2 + m) * 2816 + colf + 4 * n) = acc[0][1][m][n]; }
        }
        if (wr == 1 && fr == 15) {
#pragma unroll
            for (int n = 0; n < 2; ++n)
#pragma unroll
                for (int jj = 0; jj < 2; ++jj) *(f32x4*)(hlast + ((size_t)u.pm * 2 + jj) * 2816 + colf + 4 * n) = acc[1][0][jj + 2][n];
        }
        asm volatile("s_waitcnt lgkmcnt(0)" ::: "memory"); __builtin_amdgcn_s_barrier(); asm volatile("" ::: "memory");
        f32x4 w0[2], w1[2], w2[2];
#pragma unroll
        for (int n = 0; n < 2; ++n) { const int cl = wc * 32 + 8 * fq + 4 * n; w0[n] = *(const PG8_LAS f32x4*)(sf + 256 + cl); w1[n] = *(const PG8_LAS f32x4*)(sf + 384 + cl); w2[n] = *(const PG8_LAS f32x4*)(sf + 512 + cl); }
        const int swid = (wr == 1) ? wc : (4 + wc);
#pragma unroll
        for (int ai = 0; ai < 2; ++ai) { const int sai = (wr == 1) ? ai : 0; u32x4 w[4];
#pragma unroll
            for (int n = 0; n < 2; ++n) { f32x4 pv[2];
#pragma unroll
                for (int jj = 0; jj < 2; ++jj) { pv[jj] = (f32x4){0.f, 0.f, 0.f, 0.f}; if (fr == 0 && (wr == 1 || ai == 1)) pv[jj] = xl[swid * 64 + ((sai * 2 + n) * 4 + fq) * 2 + jj]; }
                const f32x4 g0 = acc[ai][0][0][n], g1 = acc[ai][0][1][n], g2 = acc[ai][0][2][n], g3 = acc[ai][0][3][n];
                const f32x4 P2 = shr1v(g2, pv[0]), P3 = shr1v(g3, pv[1]);
                f32x4 o[4];
                o[0] = w0[n] * P2 + w1[n] * P3 + w2[n] * g0; o[1] = w0[n] * P3 + w1[n] * g0 + w2[n] * g1; o[2] = w0[n] * g0 + w1[n] * g1 + w2[n] * g2; o[3] = w0[n] * g1 + w1[n] * g2 + w2[n] * g3;
#pragma unroll
                for (int m = 0; m < 4; ++m) { const f32x4 up = acc[ai][1][m][n];
                    const unsigned a = cvt_pk_bf16(silu_f(o[m][0]) * up[0], silu_f(o[m][1]) * up[1]), b = cvt_pk_bf16(silu_f(o[m][2]) * up[2], silu_f(o[m][3]) * up[3]);
                    if (n == 0) { w[m].x = a; w[m].y = b; } else { w[m].z = a; w[m].w = b; } } }
#pragma unroll
            for (int m = 0; m < 4; ++m) st16<2>(act + (size_t)(row0 + ai * HALF + m) * 2816 + colf, w[m]);
        }
    }
};

template <class Epi, class Sched, bool ALIGN_EPI = false, bool SP2 = false>
__device__ __forceinline__ void gemm_phase(PG8_LAS unsigned char* lds, const Gemm g, const Sched& S, const Epi& E, int tid_in) {
    int tid_o = tid_in; asm volatile("" : "+v"(tid_o));
    const int tid = tid_o, wid = __builtin_amdgcn_readfirstlane(tid >> 6), lane = tid & 63, wr = wid >> 2, wc = wid & 3, fr = lane & 15, fq = lane >> 4;
    const int K = g.K, nt = K / BK;
    unsigned voffA[2], voffB[2];
#pragma unroll
    for (int i = 0; i < 2; ++i) { int R, C; stage_rc(tid * 16 + i * 8192, R, C); const int Rb = Epi::PERM ? ((R & ~31) + perm32(R & 31)) : R;
        const int Ra = Epi::APERM ? ((R & ~63) + 4 * (R & 15) + ((R >> 4) & 3)) : R;
        voffA[i] = (unsigned)(Ra * K + C) * 2u; voffB[i] = (unsigned)(Rb * K + C) * 2u; }
    const size_t kstep = (size_t)(BK * 2);
    const size_t hstep = (size_t)HALF * K * 2;
    const size_t tstep = 2 * hstep;
    const unsigned ldsw = (unsigned)wid * 1024u;
    const int aoff = lds_byte(wr * 64 + fr, fq * 8), boff = lds_byte(wc * 32 + fr, fq * 8);
#define PG8_SA(b, h) (((b) * 2 + (h)) * HTB)
#define PG8_SB(b, h) ((4 + (b) * 2 + (h)) * HTB)
#define PG8_STAGE(bufoff, gbase, voff) do { _Pragma("unroll") for (int _i = 0; _i < 2; ++_i) \
        __builtin_amdgcn_global_load_lds((const unsigned*)((const char*)(gbase) + (voff)[_i]), (PG8_LAS unsigned*)(lds + (bufoff) + ldsw + _i * 8192), 16, 0, 0); } while (0)
#define PG8_LDA(dst, b, h) do { _Pragma("unroll") for (int m = 0; m < 4; ++m) _Pragma("unroll") for (int k = 0; k < 2; ++k) dst[m][k] = *(const PG8_LAS bf16x8*)(lds + PG8_SA(b, h) + aoff + m * 2048 + k * 1024); } while (0)
#define PG8_LDB(dst, b, h) do { _Pragma("unroll") for (int n = 0; n < 2; ++n) _Pragma("unroll") for (int k = 0; k < 2; ++k) dst[n][k] = *(const PG8_LAS bf16x8*)(lds + PG8_SB(b, h) + boff + n * 2048 + k * 1024); } while (0)
#ifndef PG8_KOUTER
#define PG8_KOUTER 1
#endif
#if PG8_KOUTER
#define PG8_MMA_LOOPS _Pragma("unroll") for (int k = 0; k < 2; ++k) _Pragma("unroll") for (int m = 0; m < 4; ++m) _Pragma("unroll") for (int n = 0; n < 2; ++n)
#else
#define PG8_MMA_LOOPS _Pragma("unroll") for (int m = 0; m < 4; ++m) _Pragma("unroll") for (int n = 0; n < 2; ++n) _Pragma("unroll") for (int k = 0; k < 2; ++k)
#endif
#ifndef PG8_PRIO
#define PG8_PRIO 1
#endif
#define PG8_MMA(ai, bj, At, Bt) do { if (PG8_PRIO) __builtin_amdgcn_s_setprio(PG8_PRIO); PG8_MMA_LOOPS \
        acc[ai][bj][m][n] = __builtin_amdgcn_mfma_f32_16x16x32_bf16(Bt[n][k], At[m][k], acc[ai][bj][m][n], 0, 0, 0); if (PG8_PRIO) __builtin_amdgcn_s_setprio(0); } while (0)
#define PG8_WAIT_V(n) asm volatile("s_waitcnt vmcnt(" #n ")" ::: "memory")
#define PG8_WAIT_L(n) asm volatile("s_waitcnt lgkmcnt(" #n ")" ::: "memory")
#define PG8_BAR __builtin_amdgcn_s_barrier()
#define PG8_SCHED __builtin_amdgcn_sched_barrier(0)
    Unit cur, nxt; int ui = 0;
    if (!S.next(0, cur)) return;
    f32x4 acc[2][2][4][2];
#pragma unroll
    for (int a = 0; a < 2; ++a)
#pragma unroll
        for (int b = 0; b < 2; ++b)
#pragma unroll
            for (int m = 0; m < 4; ++m)
#pragma unroll
                for (int n = 0; n < 2; ++n) acc[a][b][m][n] = (f32x4){0.f, 0.f, 0.f, 0.f};
    bf16x8 At[4][2], B0[2][2], B1[2][2];
    const char* cA = (const char*)g.A + (size_t)cur.pm * tstep; const char* cB = (const char*)g.Bt + (size_t)cur.pn * tstep;
    S.a_ready(cur);
    E.side(cur, lds, 0, wid, lane);
    if constexpr (SP2) {
        PG8_STAGE(PG8_SB(0, 0), cB, voffB); PG8_STAGE(PG8_SB(0, 1), cB + hstep, voffB); PG8_STAGE(PG8_SA(0, 0), cA, voffA); PG8_STAGE(PG8_SA(0, 1), cA + hstep, voffA);
        if (wr == 1) PG8_BAR;
        PG8_WAIT_V(2); PG8_BAR;
        PG8_STAGE(PG8_SB(1, 0), cB + kstep, voffB); PG8_STAGE(PG8_SA(1, 0), cA + kstep, voffA); PG8_STAGE(PG8_SB(1, 1), cB + hstep + kstep, voffB);
        PG8_WAIT_V(6); PG8_BAR;
    } else {
        PG8_STAGE(PG8_SB(0, 0), cB, voffB); PG8_STAGE(PG8_SA(0, 0), cA, voffA); PG8_STAGE(PG8_SB(0, 1), cB + hstep, voffB); PG8_STAGE(PG8_SA(0, 1), cA + hstep, voffA);
        if (wr == 1) PG8_BAR;
        PG8_WAIT_V(4); PG8_BAR;
        PG8_STAGE(PG8_SB(1, 0), cB + kstep, voffB); PG8_STAGE(PG8_SA(1, 0), cA + kstep, voffA); PG8_STAGE(PG8_SB(1, 1), cB + hstep + kstep, voffB);
        PG8_WAIT_V(6); PG8_BAR;
    }
    for (;;) {
        const bool has_next = S.next(ui + 1, nxt);
        const char* nA = has_next ? (const char*)g.A + (size_t)nxt.pm * tstep : cA; const char* nB = has_next ? (const char*)g.Bt + (size_t)nxt.pn * tstep : cB;
        for (int t = 0; t < nt; t += 2) {
            const bool last = (t == nt - 2);
            const char* a1 = cA + (size_t)(t + 1) * kstep;
            const char* a2 = last ? nA : cA + (size_t)(t + 2) * kstep; const char* b2 = last ? nB : cB + (size_t)(t + 2) * kstep;
            const char* a3 = a2 + kstep; const char* b3 = b2 + kstep;
            if (last && has_next) S.a_ready(nxt);
            if constexpr (SP2) {
            PG8_LDB(B0, 0, 0); PG8_LDB(B1, 0, 1); PG8_SCHED; PG8_LDA(At, 0, 0); PG8_STAGE(PG8_SA(1, 1), a1 + hstep, voffA);
            PG8_WAIT_V(8); PG8_WAIT_L(0); PG8_BAR; PG8_MMA(0, 0, At, B0); PG8_MMA(0, 1, At, B1); PG8_BAR; PG8_SCHED;
            PG8_LDA(At, 0, 1); PG8_STAGE(PG8_SB(0, 0), b2, voffB); PG8_STAGE(PG8_SB(0, 1), b2 + hstep, voffB); PG8_STAGE(PG8_SA(0, 0), a2, voffA);
            PG8_WAIT_V(8); PG8_WAIT_L(0); PG8_BAR; PG8_MMA(1, 0, At, B0); PG8_MMA(1, 1, At, B1); PG8_BAR; PG8_SCHED;
            PG8_LDB(B0, 1, 0); PG8_LDB(B1, 1, 1); PG8_SCHED; PG8_LDA(At, 1, 0); PG8_STAGE(PG8_SA(0, 1), a2 + hstep, voffA);
            PG8_WAIT_V(8); PG8_WAIT_L(0); PG8_BAR; PG8_MMA(0, 0, At, B0); PG8_MMA(0, 1, At, B1); PG8_BAR; PG8_SCHED;
            PG8_LDA(At, 1, 1); PG8_STAGE(PG8_SB(1, 0), b3, voffB); PG8_STAGE(PG8_SB(1, 1), b3 + hstep, voffB); PG8_STAGE(PG8_SA(1, 0), a3, voffA);
            PG8_WAIT_V(8); PG8_WAIT_L(0); PG8_BAR; PG8_MMA(1, 0, At, B0); PG8_MMA(1, 1, At, B1); PG8_BAR; PG8_SCHED;
            } else {
            PG8_LDB(B0, 0, 0); PG8_SCHED; PG8_LDA(At, 0, 0); PG8_STAGE(PG8_SA(1, 1), a1 + hstep, voffA);
            PG8_WAIT_L(8); PG8_BAR; PG8_WAIT_L(0); PG8_MMA(0, 0, At, B0); PG8_BAR; PG8_SCHED;
            PG8_LDB(B1, 0, 1); PG8_STAGE(PG8_SB(0, 0), b2, voffB);
            PG8_BAR; PG8_WAIT_L(0); PG8_MMA(0, 1, At, B1); PG8_BAR;
            PG8_LDA(At, 0, 1); PG8_STAGE(PG8_SA(0, 0), a2, voffA);
            PG8_BAR; PG8_WAIT_L(0); PG8_MMA(1, 0, At, B0); PG8_BAR; PG8_SCHED;
            PG8_STAGE(PG8_SB(0, 1), b2 + hstep, voffB);
            PG8_WAIT_V(6); PG8_BAR; PG8_MMA(1, 1, At, B1); PG8_BAR;
            PG8_LDB(B0, 1, 0); PG8_SCHED; PG8_LDA(At, 1, 0); PG8_STAGE(PG8_SA(0, 1), a2 + hstep, voffA);
            PG8_WAIT_L(8); PG8_BAR; PG8_WAIT_L(0); PG8_MMA(0, 0, At, B0); PG8_BAR; PG8_SCHED;
            PG8_LDB(B1, 1, 1); PG8_STAGE(PG8_SB(1, 0), b3, voffB);
            PG8_BAR; PG8_WAIT_L(0); PG8_MMA(0, 1, At, B1); PG8_BAR;
            PG8_LDA(At, 1, 1); PG8_STAGE(PG8_SA(1, 0), a3, voffA);
            PG8_BAR; PG8_WAIT_L(0); PG8_MMA(1, 0, At, B0); PG8_BAR; PG8_SCHED;
            PG8_STAGE(PG8_SB(1, 1), b3 + hstep, voffB);
            PG8_WAIT_V(6); PG8_BAR; PG8_MMA(1, 1, At, B1); PG8_BAR;
            }
        }
        if constexpr (ALIGN_EPI) { if (wr == 0) PG8_BAR; }
        if constexpr (!Epi::AFTER_DRAIN) { E(acc, cur, wr, wc, fr, fq, ui & 1);
#ifdef PROBE_EPI_TWICE
            if constexpr (Epi::TWICE) { if (E.twice(cur)) E(acc, cur, wr, wc, fr, fq, ui & 1, true); }
#endif
            S.done(cur); }
        if (!has_next) break;
#pragma unroll
        for (int a = 0; a < 2; ++a)
#pragma unroll
            for (int b = 0; b < 2; ++b)
#pragma unroll
                for (int m = 0; m < 4; ++m)
#pragma unroll
                    for (int n = 0; n < 2; ++n) acc[a][b][m][n] = (f32x4){0.f, 0.f, 0.f, 0.f};
        cur = nxt; cA = nA; cB = nB; ++ui;
        E.side(cur, lds, ui & 1, wid, lane);
        if constexpr (ALIGN_EPI) { if (wr == 1) PG8_BAR; }
    }
    PG8_WAIT_V(0);
    if constexpr (!ALIGN_EPI) { if (wr == 0) PG8_BAR; }
    PG8_BAR;
    if constexpr (Epi::AFTER_DRAIN) { E.fused(acc, cur, wr, wc, fr, fq, lds, wid, lane); S.done(cur); }
#undef PG8_SA
#undef PG8_SB
#undef PG8_STAGE
#undef PG8_LDA
#undef PG8_LDB
#undef PG8_MMA
#undef PG8_WAIT_V
#undef PG8_WAIT_L
#undef PG8_BAR
#undef PG8_SCHED
}
}
#ifndef PG8_SP2
#define PG8_SP2 true
#endif
#ifndef MK_SPLIT
#define MK_SPLIT 0
#endif

constexpr int NWAVES = 8, NTHREADS = 512;
constexpr int DM = 1024, SEQ = 4096, NB = 8, T = NB * SEQ, INC = 3592, NIN = 3584, DFF = 2816, NGU = 2 * DFF, DEPTH = 2;
constexpr int NPHASE = 2 + 6 * DEPTH;
constexpr size_t MiB = 1u << 20;
constexpr size_t WS_CTL = 0, CTL_ZERO_BYTES = 2 * MiB;
constexpr size_t WS_SUMSQ = 512 * 1024;
static_assert(WS_SUMSQ + 5 * (size_t)T * 8 <= CTL_ZERO_BYTES, "sumsq inside the zeroed region");
constexpr size_t WS_WLOG = 2 * MiB;
constexpr size_t WS_BG = 3 * MiB;
constexpr size_t WS_HFIRST = 4 * MiB, WS_UFIRST = 7 * MiB, WS_HLAST = 10 * MiB;
constexpr size_t WS_WIN = 16 * MiB, WS_WOUT = 30 * MiB, WS_WGU = 34 * MiB, WS_WD = 56 * MiB;
constexpr size_t WS_XB = 68 * MiB;
constexpr size_t WS_PA = 132 * MiB;
constexpr size_t WS_Z = 228 * MiB;
constexpr size_t WS_QKV = 260 * MiB;
constexpr size_t WS_ACT = 132 * MiB;
constexpr size_t WS_REC1 = 356 * MiB;
constexpr size_t WS_REC0 = 437 * MiB;
#define Y_BASE(F) ((unsigned char*)(F).out)
constexpr size_t WS_QFIRST = 501 * MiB, WS_QLAST = 504 * MiB;
constexpr size_t WS_END = 507 * MiB;
constexpr int REC_BYTES_C = 73728, REC0_N = 910;
static_assert((size_t)REC0_N * REC_BYTES_C <= 64 * MiB && (size_t)(2048 - REC0_N) * REC_BYTES_C <= 81 * MiB, "record regions");
constexpr int CW_BAR = 4096;
constexpr int RING_OFF = 0, RING_BYTES = 131072;
constexpr int XL_OFF = RING_BYTES;
constexpr int LDS_BYTES = 163840;
constexpr int LDSCTL_OFF = LDS_BYTES - 1024, MISC_OFF = LDSCTL_OFF + 320;

#define GAS __attribute__((address_space(1)))
#define LAS __attribute__((address_space(3)))
typedef unsigned short bf16;
typedef unsigned v4u __attribute__((ext_vector_type(4)));
typedef unsigned v2u __attribute__((ext_vector_type(2)));
typedef float f32x4 __attribute__((ext_vector_type(4)));
typedef short bf16x8 __attribute__((ext_vector_type(8)));
#define LDS_WAIT() asm volatile("s_waitcnt lgkmcnt(0)" ::: "memory")
#define VM_WAIT() asm volatile("s_waitcnt vmcnt(0)" ::: "memory")
__device__ __forceinline__ unsigned f2bf(float f) { unsigned u = __builtin_bit_cast(unsigned, f); return (u + 0x7fffu + ((u >> 16) & 1u)) >> 16; }
__device__ __forceinline__ unsigned pk2(float lo, float hi) { return f2bf(lo) | (f2bf(hi) << 16); }
__device__ __forceinline__ float bf2f(bf16 b) { return __builtin_bit_cast(float, ((unsigned)b) << 16); }
__device__ __forceinline__ float bflo(unsigned w) { return __builtin_bit_cast(float, w << 16); }
__device__ __forceinline__ float bfhi(unsigned w) { return __builtin_bit_cast(float, w & 0xffff0000u); }

#define XB_TMO      128
#define XB_XCNT(j)  (256  + 64 * (j))
#define XB_XSUB(j)  (1280 + 64 * (j))
#define XB_XGEN(j)  (2304 + 64 * (j))
#define XB_TOP      3328
#define XB_TOPGEN   3392
#define XCD_BAR_WORDS 3456
#define XB_SPIN_CAP (1u << 22)
__device__ __forceinline__ unsigned xb_ld(unsigned* p)              { return __hip_atomic_load(p, __ATOMIC_RELAXED, __HIP_MEMORY_SCOPE_AGENT); }
__device__ __forceinline__ unsigned xb_add(unsigned* p, unsigned v) { return __hip_atomic_fetch_add(p, v, __ATOMIC_RELAXED, __HIP_MEMORY_SCOPE_AGENT); }
__device__ __forceinline__ unsigned xb_xcc_id() { return (unsigned)__builtin_amdgcn_s_getreg((3 << 11) | 20) & 0xFu; }
#define XB_SPIN(cond, bar) do { unsigned _sp = 0; while (cond) { __builtin_amdgcn_s_sleep(1); \
    if ((++_sp & 255u) == 0u) { if (xb_ld(&(bar)[XB_TMO])) break; if (_sp > XB_SPIN_CAP) { atomicAdd(&(bar)[XB_TMO], 1u); break; } } } } while (0)
struct XcdBarrier { unsigned* bar; unsigned x; volatile LAS unsigned* st; };
__device__ __forceinline__ XcdBarrier xcd_barrier_post(unsigned* bar, volatile LAS unsigned* st) {
    XcdBarrier b; b.bar = bar; b.x = xb_xcc_id(); b.st = st;
    if (threadIdx.x == 0) (void)xb_add(&bar[XB_XCNT(b.x)], 1u);
    return b;
}
__device__ __forceinline__ void xcd_barrier_complete(unsigned* bar, unsigned x, unsigned& nloc, unsigned& nx) {
    const unsigned G = gridDim.x * gridDim.y * gridDim.z;
    unsigned sum, cnt, mine, sp = 0u;
    for (;;) {
        sum = 0u; cnt = 0u; mine = 0u;
#pragma unroll
        for (unsigned j = 0; j < 16; ++j) { const unsigned c = xb_ld(&bar[XB_XCNT(j)]); sum += c; cnt += (c > 0u) ? 1u : 0u; mine = (j == x) ? c : mine; }
        if (sum == G) break;
        __builtin_amdgcn_s_sleep(1);
        if ((++sp & 255u) == 0u) { if (xb_ld(&bar[XB_TMO])) break; if (sp > XB_SPIN_CAP) { atomicAdd(&bar[XB_TMO], 1u); break; } }
    }
    nloc = mine > 0u ? mine : 1u; nx = cnt > 0u ? cnt : 1u;
}
__device__ __forceinline__ void xcd_census(const XcdBarrier& b) {
    if (b.st[0] == 0u && threadIdx.x < 64u) {
        const unsigned ln = threadIdx.x, G = gridDim.x * gridDim.y * gridDim.z; unsigned c = 0u, sum = 0u;
        for (unsigned sp = 0; sp < XB_SPIN_CAP; ++sp) {
            c = (ln < 16u) ? xb_ld(&b.bar[XB_XCNT(ln)]) : 0u; sum = c;
#pragma unroll
            for (int o = 1; o < 16; o <<= 1) sum += __shfl_xor(sum, o);
            sum = __shfl(sum, 0);
            if (sum == G) break;
            __builtin_amdgcn_s_sleep(1);
            if ((sp & 255u) == 255u && xb_ld(&b.bar[XB_TMO])) break;
        }
        if (sum != G && ln == 0u) atomicAdd(&b.bar[XB_TMO], 1u);
        const unsigned long long nz = __ballot(c > 0u); const unsigned mine = __shfl(c, (int)b.x);
        if (ln == 0u) { b.st[0] = mine > 0u ? mine : 1u; b.st[1] = nz ? (unsigned)__popcll(nz) : 1u; }
        asm volatile("s_waitcnt lgkmcnt(0)" ::: "memory");
    }
}
__device__ __forceinline__ void xcd_barrier(const XcdBarrier& b) {
    asm volatile("s_waitcnt vmcnt(0)" ::: "memory");
    __syncthreads();
    if (threadIdx.x == 0) {
        unsigned* bar = b.bar;
        __builtin_amdgcn_s_waitcnt(0);
        unsigned nloc = b.st[0], nx = b.st[1];
        if (nloc == 0u) { xcd_barrier_complete(bar, b.x, nloc, nx); b.st[0] = nloc; b.st[1] = nx; }
        const unsigned old = xb_add(&bar[XB_XSUB(b.x)], 1u);
        const unsigned gen = old / nloc;
        if (old + 1u == (gen + 1u) * nloc) {
            __builtin_amdgcn_fence(__ATOMIC_RELEASE, "agent");
            asm volatile("s_waitcnt vmcnt(0)" ::: "memory");
            const unsigned og = xb_add(&bar[XB_TOP], 1u);
            const unsigned tg = og / nx;
            if (og + 1u == (tg + 1u) * nx) xb_add(&bar[XB_TOPGEN], 1u);
            else XB_SPIN(xb_ld(&bar[XB_TOPGEN]) == tg, bar);
            __builtin_amdgcn_fence(__ATOMIC_ACQUIRE, "agent");
            xb_add(&bar[XB_XGEN(b.x)], 1u);
            asm volatile("s_waitcnt vmcnt(0)" ::: "memory");
        } else {
            XB_SPIN(xb_ld(&bar[XB_XGEN(b.x)]) == gen, bar);
            __builtin_amdgcn_fence(__ATOMIC_ACQUIRE, "agent");
            asm volatile("s_waitcnt vmcnt(0)" ::: "memory");
        }
    }
    __syncthreads();
}

struct Args { const float* in[14]; float* out; unsigned char* ws; int ph_lo, ph_hi; };
struct Frame {
    LAS unsigned char* lds;
    int tid, lane, wave, G, bid;
    const float *x, *ln1, *w_in, *conv_qkv, *a_log, *dt_bias, *gdn_norm, *w_out, *ln2, *w_gate, *w_up, *ffn_conv, *w_down, *ln_f;
    float* out; unsigned char* ws;
};
__device__ __forceinline__ float wave_sum(float v) {
#pragma unroll
    for (int o = 1; o < 64; o <<= 1) v += __shfl_xor(v, o);
    return v;
}
__device__ __forceinline__ float silu_acc(float v) { return v / (1.0f + __expf(-v)); }

template <bool GAIN>
__device__ __forceinline__ void p0_transpose_item(const float* W, int ldw, int c0, int k0, int K, bf16* WT, int r0, const float* gain, LAS float* scr, int lane) {
    f32x4 v[8]; float gv[8];
#pragma unroll
    for (int i = 0; i < 8; ++i) { const int kk = 8 * i + (lane >> 3); v[i] = *(const f32x4*)(W + (size_t)(k0 + kk) * ldw + c0 + 4 * (lane & 7)); gv[i] = GAIN ? gain[k0 + kk] : 1.f; }
#pragma unroll
    for (int i = 0; i < 8; ++i) { const int kk = 8 * i + (lane >> 3), cc = 4 * (lane & 7); const f32x4 x = GAIN ? v[i] * gv[i] : v[i];
        scr[kk * 33 + cc] = x.x; scr[kk * 33 + cc + 1] = x.y; scr[kk * 33 + cc + 2] = x.z; scr[kk * 33 + cc + 3] = x.w; }
    LDS_WAIT(); asm volatile("" ::: "memory");
    const int c = lane & 7;
#pragma unroll
    for (int j = 0; j < 4; ++j) { const int n = (lane >> 3) + 8 * j; const LAS float* s = scr + (8 * c) * 33 + n;
        v4u o; o.x = pk2(s[0 * 33], s[1 * 33]); o.y = pk2(s[2 * 33], s[3 * 33]); o.z = pk2(s[4 * 33], s[5 * 33]); o.w = pk2(s[6 * 33], s[7 * 33]);
        *(v4u*)(WT + (size_t)(r0 + n) * K + k0 + 8 * c) = o; }
    LDS_WAIT(); asm volatile("" ::: "memory");
}
__device__ __forceinline__ void phase_p0(Frame& F) {
    LAS float* scr = (LAS float*)(F.lds + RING_OFF + F.wave * 16384);
    const int gw = F.bid * NWAVES + F.wave, NGW = F.G * NWAVES;
    constexpr int KB = DM / 64, KBD = DFF / 64;
    constexpr int I_IN = KB * (NIN / 32), I_OUT = KB * (DM / 32), I_GU = KB * (NGU / 32), I_D = KBD * (DM / 32), I_L = I_IN + I_OUT + I_GU + I_D;
    for (int it = gw; it < DEPTH * I_L; it += NGW) {
        const int l = it / I_L; int r = it % I_L;
        if (r < I_IN) { const int kb = r / (NIN / 32), nb = r % (NIN / 32), r0 = 32 * nb, c0 = r0 + (r0 >= 2048 ? 8 : 0);
            p0_transpose_item<true>(F.w_in + (size_t)l * DM * INC, INC, c0, 64 * kb, DM, (bf16*)(F.ws + WS_WIN) + (size_t)l * NIN * DM, r0, F.ln1 + l * DM, scr, F.lane); continue; } r -= I_IN;
        if (r < I_OUT) { const int kb = r / (DM / 32), nb = r % (DM / 32);
            p0_transpose_item<false>(F.w_out + (size_t)l * DM * DM, DM, 32 * nb, 64 * kb, DM, (bf16*)(F.ws + WS_WOUT) + (size_t)l * DM * DM, 32 * nb, nullptr, scr, F.lane); continue; } r -= I_OUT;
        if (r < I_GU) { const int kb = r / (NGU / 32), nb = r % (NGU / 32), r0 = 32 * nb, pn = r0 >> 8, rr = r0 & 255;
            const float* W = (rr < 128) ? F.w_gate : F.w_up; const int c0 = 128 * pn + (rr & 127);
            p0_transpose_item<true>(W + (size_t)l * DM * DFF, DFF, c0, 64 * kb, DM, (bf16*)(F.ws + WS_WGU) + (size_t)l * NGU * DM, r0, F.ln2 + l * DM, scr, F.lane); continue; } r -= I_GU;
        { const int kb = r / (DM / 32), nb = r % (DM / 32);
            p0_transpose_item<false>(F.w_down + (size_t)l * DFF * DM, DM, 32 * nb, 64 * kb, DFF, (bf16*)(F.ws + WS_WD) + (size_t)l * DM * DFF, 32 * nb, nullptr, scr, F.lane); }
    }
    for (int i = F.bid * NTHREADS + F.tid; i < DEPTH * 8 * DM; i += F.G * NTHREADS) { const int l = i / (8 * DM), j = (i / DM) % 8, k = i % DM;
        ((bf16*)(F.ws + WS_WLOG))[i] = (bf16)f2bf(F.w_in[(size_t)l * DM * INC + (size_t)k * INC + 2048 + j] * F.ln1[l * DM + k]); }
    pg8::ssq_t* ss0 = (pg8::ssq_t*)(F.ws + WS_SUMSQ);
    for (int m0 = gw * 4; m0 < T; m0 += NGW * 4) {
        f32x4 v[4][4];
#pragma unroll
        for (int r = 0; r < 4; ++r) { const f32x4* xr = (const f32x4*)(F.x + (size_t)(m0 + r) * DM) + F.lane;
#pragma unroll
            for (int j = 0; j < 4; ++j) v[r][j] = xr[64 * j]; }
#pragma unroll
        for (int r = 0; r < 4; ++r) { float s = 0.f;
#pragma unroll
            for (int j = 0; j < 4; ++j) s += (v[r][j].x * v[r][j].x + v[r][j].y * v[r][j].y) + (v[r][j].z * v[r][j].z + v[r][j].w * v[r][j].w);
            s = wave_sum(s);
            unsigned long long* o8 = (unsigned long long*)((bf16*)(F.ws + WS_XB) + (size_t)(m0 + r) * DM) + F.lane;
#pragma unroll
            for (int j = 0; j < 4; ++j) o8[64 * j] = (unsigned long long)pk2(v[r][j].x, v[r][j].y) | ((unsigned long long)pk2(v[r][j].z, v[r][j].w) << 32);
            if (F.lane == 0) ss0[m0 + r] = pg8::ssq_pack(s); }
    }
}
constexpr int R_AQ = 32768, R_KT = 40960, R_U = 57344, REC_BYTES = REC_BYTES_C, REC_LDS = 57344, QTR = 14336;
__device__ __forceinline__ constexpr int R_WNF(int f) { return 2048 * f; }
__device__ __forceinline__ constexpr int R_QDF(int f) { return 2048 * f + 1024; }
__device__ __forceinline__ unsigned char* rec_ptr(const Frame& F, int r) { return r < REC0_N ? F.ws + WS_REC0 + (size_t)r * REC_BYTES : F.ws + WS_REC1 + (size_t)(r - REC0_N) * REC_BYTES; }
constexpr int R_DL = R_AQ + 2048;
constexpr int PI_ST = 272, P_QB = 0, P_KB = 17408, P_RV = 34816, P_RK = 52224, P_AM = 69632, P_TT = 87040, P_TC = 104448, P_XT = 121856, P_YT = 124416, P_LG = 129024, P_GC = 131072, P_LP = 139264;
__device__ __forceinline__ int kperm(int s, int hh, int jj) { return 16 * s + 8 * (jj >> 2) + 4 * hh + (jj & 3); }
__device__ __forceinline__ float dpp_xor1(float v) { return __builtin_bit_cast(float, __builtin_amdgcn_update_dpp(0, __builtin_bit_cast(int, v), 0xB1, 0xf, 0xf, false)); }
typedef float f32x16 __attribute__((ext_vector_type(16)));
typedef short s16x4 __attribute__((ext_vector_type(4)));
#define MFMA32(a, b, c) __builtin_amdgcn_mfma_f32_32x32x16_bf16((a), (b), (c), 0, 0, 0)
__device__ __forceinline__ bf16x8 pack8(const f32x16& x, int s) {
    v4u o; o.x = pg8::cvt_pk_bf16(x[8 * s + 0], x[8 * s + 1]); o.y = pg8::cvt_pk_bf16(x[8 * s + 2], x[8 * s + 3]); o.z = pg8::cvt_pk_bf16(x[8 * s + 4], x[8 * s + 5]); o.w = pg8::cvt_pk_bf16(x[8 * s + 6], x[8 * s + 7]);
    return __builtin_bit_cast(bf16x8, o);
}
__device__ __forceinline__ bf16x8 cvt8(const f32x4 a, const f32x4 b) {
    v4u o; o.x = pg8::cvt_pk_bf16(a[0], a[1]); o.y = pg8::cvt_pk_bf16(a[2], a[3]); o.z = pg8::cvt_pk_bf16(b[0], b[1]); o.w = pg8::cvt_pk_bf16(b[2], b[3]); return __builtin_bit_cast(bf16x8, o);
}
__device__ __forceinline__ bf16x8 tr_frag(const LAS unsigned char* img, int r0, int rstep, int c0, int lane) {
    const LAS unsigned char* p = img + (r0 + ((lane & 15) >> 2)) * PI_ST + (c0 + 16 * ((lane >> 4) & 1) + 4 * (lane & 3)) * 2;
    const s16x4 lo = __builtin_amdgcn_ds_read_tr16_b64_v4i16((LAS s16x4*)p), hi = __builtin_amdgcn_ds_read_tr16_b64_v4i16((LAS s16x4*)(p + rstep * PI_ST));
    return (bf16x8){lo[0], lo[1], lo[2], lo[3], hi[0], hi[1], hi[2], hi[3]};
}
#ifndef DUP_RECORDS
#define DUP_RECORDS 0
#endif
__device__ __forceinline__ void st_wt16_raw(void* p, v4u v) { asm volatile("global_store_dwordx4 %0, %1, off sc1\n\ts_nop 1" :: "v"(p), "v"(v) : "memory"); }
__device__ __forceinline__ void st_wt16x(void* p, v4u v, long long dup) { st_wt16_raw(p, v); if (DUP_RECORDS && dup) st_wt16_raw((char*)p + dup, v); }
#define st_wt16(p, v) st_wt16x((p), (v), dupd)
__device__ __forceinline__ float wave_sum_dpp(float v) {
    v += __builtin_bit_cast(float, __builtin_amdgcn_update_dpp(0, __builtin_bit_cast(int, v), 0x111, 0xf, 0xf, true));
    v += __builtin_bit_cast(float, __builtin_amdgcn_update_dpp(0, __builtin_bit_cast(int, v), 0x112, 0xf, 0xf, true));
    v += __builtin_bit_cast(float, __builtin_amdgcn_update_dpp(0, __builtin_bit_cast(int, v), 0x114, 0xf, 0xf, true));
    v += __builtin_bit_cast(float, __builtin_amdgcn_update_dpp(0, __builtin_bit_cast(int, v), 0x118, 0xf, 0xf, true));
    v += __builtin_bit_cast(float, __builtin_amdgcn_update_dpp(0, __builtin_bit_cast(int, v), 0x142, 0xa, 0xf, false));
    v += __builtin_bit_cast(float, __builtin_amdgcn_update_dpp(0, __builtin_bit_cast(int, v), 0x143, 0xc, 0xf, false));
    return __builtin_bit_cast(float, __builtin_amdgcn_readlane(__builtin_bit_cast(int, v), 63));
}
__device__ __forceinline__ float wave_scan_dpp(float v) {
    v += __builtin_bit_cast(float, __builtin_amdgcn_update_dpp(0, __builtin_bit_cast(int, v), 0x111, 0xf, 0xf, true));
    v += __builtin_bit_cast(float, __builtin_amdgcn_update_dpp(0, __builtin_bit_cast(int, v), 0x112, 0xf, 0xf, true));
    v += __builtin_bit_cast(float, __builtin_amdgcn_update_dpp(0, __builtin_bit_cast(int, v), 0x114, 0xf, 0xf, true));
    v += __builtin_bit_cast(float, __builtin_amdgcn_update_dpp(0, __builtin_bit_cast(int, v), 0x118, 0xf, 0xf, true));
    v += __builtin_bit_cast(float, __builtin_amdgcn_update_dpp(0, __builtin_bit_cast(int, v), 0x142, 0xa, 0xf, false));
    v += __builtin_bit_cast(float, __builtin_amdgcn_update_dpp(0, __builtin_bit_cast(int, v), 0x143, 0xc, 0xf, false));
    return v;
}
__device__ __forceinline__ void logits_phase(Frame& F, int l, const pg8::ssq_t* sumsq) {
    LAS unsigned char* L = F.lds; LAS float* LP = (LAS float*)(L + P_LP);
    const bf16* xb = (const bf16*)(F.ws + WS_XB); const bf16* wlb = (const bf16*)(F.ws + WS_WLOG) + (size_t)l * 8 * DM; float* bg = (float*)(F.ws + WS_BG);
    const int lane = F.lane, wave = F.wave, tid = F.tid, hh = lane >> 5, c31 = lane & 31; const float L2E = 1.44269504089f;
    for (int t0 = F.bid * 64; t0 < T; t0 += F.G * 64) {
        {
            f32x16 C0, C1;
#pragma unroll
            for (int r = 0; r < 16; ++r) { C0[r] = 0.f; C1[r] = 0.f; }
            LAS unsigned char* ximg = L + wave * 17408;
            bf16x8 xr[16];
#pragma unroll
            for (int i = 0; i < 16; ++i) xr[i] = *(const bf16x8*)(xb + (size_t)(t0 + 4 * i + (lane >> 4)) * DM + 128 * wave + 8 * (lane & 15));
#pragma unroll
            for (int i = 0; i < 16; ++i) *(LAS bf16x8*)(ximg + (4 * i + (lane >> 4)) * 272 + 16 * (lane & 15)) = xr[i];
            const bf16* wp = wlb + (size_t)(c31 & 7) * DM + 128 * wave + 8 * hh;
#pragma unroll
            for (int ks = 0; ks < 8; ++ks) { const bf16x8 a0 = *(const LAS bf16x8*)(ximg + c31 * 272 + (16 * ks + 8 * hh) * 2), a1 = *(const LAS bf16x8*)(ximg + (32 + c31) * 272 + (16 * ks + 8 * hh) * 2);
                bf16x8 bw = *(const bf16x8*)(wp + 16 * ks); if (c31 >= 8) bw = (bf16x8){0, 0, 0, 0, 0, 0, 0, 0};
                C0 = MFMA32(a0, bw, C0); C1 = MFMA32(a1, bw, C1); }
            if (c31 < 8) {
#pragma unroll
                for (int r = 0; r < 16; ++r) { const int row = (r & 3) + 8 * (r >> 2) + 4 * hh; LP[(wave * 64 + row) * 8 + c31] = C0[r]; LP[(wave * 64 + 32 + row) * 8 + c31] = C1[r]; } }
        }
        LDS_WAIT(); __syncthreads();
        { const int tok = tid >> 3, j = tid & 7; float s = 0.f;
#pragma unroll
          for (int w = 0; w < 8; ++w) s += LP[(w * 64 + tok) * 8 + j];
          s *= __builtin_amdgcn_rsqf(pg8::ssq_val(sumsq[t0 + tok]) * (1.0f / 1024.0f) + 1e-6f);
          if (j < 4) bg[(size_t)(t0 + tok) * 8 + j] = 1.0f / (1.0f + __expf(-s));
          else { const float xx = s + F.dt_bias[l * 4 + j - 4], e = __expf(fminf(xx, 20.f));
               const float sp = xx > 20.f ? xx : (e < 0.01f ? e * (1.0f - e * (0.5f - e * 0.33333333f)) : __logf(1.0f + e));
               bg[(size_t)(t0 + tok) * 8 + j] = -__expf(F.a_log[l * 4 + j - 4]) * sp * L2E; } }
        LDS_WAIT(); __syncthreads();
        __syncthreads();
    }
}
#ifndef PREP_STAGE
#define PREP_STAGE -1
#endif
#ifndef PREP_N
#define PREP_N 0
#endif
#define PREPREP(id) (1 + ((PREP_STAGE) == (id) ? (PREP_N) : 0))
constexpr int CW_RF = 16384;
#define PREP_BAR() do { __builtin_amdgcn_s_barrier(); asm volatile("" ::: "memory"); } while (0)
struct PrepPre { unsigned rq[8], rk[8], rv[8]; float beta, g; bool have; };
#ifndef PREP_PREFETCH
#define PREP_PREFETCH 1
#endif
__device__ __forceinline__ unsigned* gdn_prep_item(Frame& F, int l, const pg8::ssq_t* sumsq, int item, int fl, unsigned* pend, PrepPre& pre, volatile LAS unsigned* bcn, unsigned nxt) {
    LAS unsigned char* L = F.lds;
    LAS float* LG = (LAS float*)(L + P_LG); LAS float* GC = (LAS float*)(L + P_GC); LAS float* LP = (LAS float*)(L + P_LP);
    LAS float* AM = (LAS float*)(L + P_AM); LAS float* TT = (LAS float*)(L + P_TT); LAS float* TC = (LAS float*)(L + P_TC); LAS float* XT = (LAS float*)(L + P_XT); LAS float* YT = (LAS float*)(L + P_YT);
    const bf16* pa = (const bf16*)(F.ws + WS_PA); const bf16* xb = (const bf16*)(F.ws + WS_XB);
    const bf16* wlb = (const bf16*)(F.ws + WS_WLOG) + (size_t)l * 8 * DM;
    const float* cw = F.conv_qkv + (size_t)l * 4 * 1536;
    int lane_o = (int)__builtin_amdgcn_mbcnt_hi(~0u, __builtin_amdgcn_mbcnt_lo(~0u, 0u)); asm volatile("" : "+v"(lane_o));
    const int lane = lane_o, wave = F.wave, tid = wave * 64 + lane, hh = lane >> 5, c31 = lane & 31;
    const float SCALE = 0.08838834764831845f, L2E = 1.44269504089f;
    {
        const int h = item & 3, b = (item >> 2) & 7, n = item >> 5, t0 = b * SEQ + n * 64;

        float betav, gcv, g;
        unsigned rq[8], rk[8], rv[8];
        if (PREP_PREFETCH && pre.have) {
            betav = pre.beta; g = pre.g;
#pragma unroll
            for (int r = 0; r < 8; ++r) { rq[r] = pre.rq[r]; rk[r] = pre.rk[r]; rv[r] = pre.rv[r]; }
        } else {
            const float* bgp = (const float*)(F.ws + WS_BG) + (size_t)(t0 + lane) * 8; betav = bgp[h]; g = bgp[4 + h];
            asm volatile("" ::: "memory");
#pragma unroll
            for (int r = 0; r < 8; ++r) { const bf16* p = pa + ((size_t)((b * 4 + h) * SEQ + n * 64 + wave * 8 + r)) * 384 + 2 * lane; rq[r] = *(const unsigned*)p; rk[r] = *(const unsigned*)(p + 128); rv[r] = *(const unsigned*)(p + 256); }
            asm volatile("" ::: "memory");
        }
        {
            g = wave_scan_dpp(g);
            gcv = g; if (wave == 0) { LG[h * 64 + lane] = betav; GC[h * 64 + lane] = g; } }
        {
            unsigned char* rec = rec_ptr(F, (b * 4 + h) * 64 + n);
            const long long dupd = (DUP_RECORDS && l == 0) ? (long long)((unsigned char*)F.out + (size_t)(((b * 4 + h) * 64 + n) % 1820) * REC_BYTES - rec) : 0ll;
            const LAS float* gc = GC + h * 64; const LAS float* beta = LG + h * 64;
            const float glast = __builtin_bit_cast(float, __builtin_amdgcn_readlane(__builtin_bit_cast(int, gcv), 63));
            for (int rp = 0; rp < PREPREP(1); ++rp) {
                #ifdef NO_SEAM_FIX
                const bool fixrows = false;
#else
                const bool fixrows = (wave == 0) && ((n & 3) == 0);
#endif
#pragma unroll
                for (int r = 0; r < 8; ++r) { const int i = wave * 8 + r;
                    float q0 = bflo(rq[r]), q1 = bfhi(rq[r]), k0 = bflo(rk[r]), k1 = bfhi(rk[r]), v0 = bflo(rv[r]), v1 = bfhi(rv[r]);
                    if (r < 3 && fixrows) {
                        const int pm = t0 >> 8; const bool halo = (pm & 15) != 0;
                        const float* qf = (const float*)(F.ws + WS_QFIRST) + (size_t)pm * 3 * 1536; const float* ql = (const float*)(F.ws + WS_QLAST) + (size_t)(halo ? pm - 1 : pm) * 3 * 1536;
                        float o[3][2];
#pragma unroll
                        for (int part = 0; part < 3; ++part)
#pragma unroll
                            for (int e = 0; e < 2; ++e) { const int c = part * 512 + h * 128 + 2 * lane + e; float s = 0.f;
#pragma unroll
                                for (int j = 0; j < 4; ++j) { const int idx = r - 3 + j;
                                    const float gval = (idx >= 0) ? qf[idx * 1536 + c] : (halo ? ql[(3 + idx) * 1536 + c] : 0.f);
                                    s += gval * cw[j * 1536 + c]; }
                                o[part][e] = pg8::silu_f(s); }
                        q0 = o[0][0]; q1 = o[0][1]; k0 = o[1][0]; k1 = o[1][1]; v0 = o[2][0]; v1 = o[2][1];
                    }
                    const float qn = __builtin_amdgcn_rsqf(wave_sum_dpp(q0 * q0 + q1 * q1) + 1e-6f), kn = __builtin_amdgcn_rsqf(wave_sum_dpp(k0 * k0 + k1 * k1) + 1e-6f);
                    q0 *= qn; q1 *= qn; k0 *= kn; k1 *= kn;
                    const float bi = __builtin_bit_cast(float, __builtin_amdgcn_readlane(__builtin_bit_cast(int, betav), i)), eg = __builtin_amdgcn_exp2f(__builtin_bit_cast(float, __builtin_amdgcn_readlane(__builtin_bit_cast(int, gcv), i)));
                    const int o2 = i * PI_ST + 4 * lane;
                    *(LAS unsigned*)(L + P_QB + o2) = pg8::cvt_pk_bf16(q0, q1); *(LAS unsigned*)(L + P_KB + o2) = pg8::cvt_pk_bf16(k0, k1);
                    *(LAS unsigned*)(L + P_RV + o2) = pg8::cvt_pk_bf16(bi * v0, bi * v1); *(LAS unsigned*)(L + P_RK + o2) = pg8::cvt_pk_bf16(bi * eg * k0, bi * eg * k1);
                }
            }
            VM_WAIT(); LDS_WAIT(); __syncthreads();
            if (pend && tid == 0) __hip_atomic_store(pend, 1u, __ATOMIC_RELAXED, __HIP_MEMORY_SCOPE_AGENT);
            if (PREP_PREFETCH && tid == 0) bcn[0] = nxt;
            for (int rp = 0; rp < PREPREP(2); ++rp)
            if (wave < 6) {
                const int blk = wave % 3, jt = (blk == 2) ? 1 : 0, it = (blk >= 1) ? 1 : 0;
                const bool isA = wave < 3;
                const LAS unsigned char* rimg = L + P_KB + (32 * jt + c31) * PI_ST + 16 * hh;
                const LAS unsigned char* cimg = L + (isA ? P_KB : P_QB) + (32 * it + c31) * PI_ST + 16 * hh;
                f32x16 C;
#pragma unroll
                for (int r = 0; r < 16; ++r) C[r] = 0.f;
#pragma unroll
                for (int ks = 0; ks < 8; ++ks) C = MFMA32(*(const LAS bf16x8*)(rimg + 32 * ks), *(const LAS bf16x8*)(cimg + 32 * ks), C);
                const int i = 32 * it + c31; const float gi = gc[i], bi = isA ? beta[i] : SCALE;
#pragma unroll
                for (int r = 0; r < 16; ++r) { const int j = 32 * jt + (r & 3) + 8 * (r >> 2) + 4 * hh; const bool ok = isA ? (i > j) : (i >= j);
                    C[r] = ok ? bi * C[r] * __builtin_amdgcn_exp2f(gi - gc[j]) : 0.f;
                    if (isA) AM[i * 68 + j] = C[r]; }
                if (!isA) {
#pragma unroll
                    for (int s = 0; s < 2; ++s) st_wt16(rec + R_AQ + ((it * 2 + jt) * 2 + s) * 1024 + lane * 16, __builtin_bit_cast(v4u, pack8(C, s))); }
            } else {
                LAS v4u* z = (LAS v4u*)(L + (wave == 6 ? P_TT : P_TC));
#pragma unroll
                for (int q = 0; q < 17; ++q) z[q * 64 + lane] = (v4u){0u, 0u, 0u, 0u};
                if (wave == 6 && lane == 0) __hip_atomic_store((float*)(rec + R_DL), __builtin_amdgcn_exp2f(glast), __ATOMIC_RELAXED, __HIP_MEMORY_SCOPE_AGENT);
            }
            LDS_WAIT(); PREP_BAR();
            for (int rp = 0; rp < PREPREP(3); ++rp) {
            if (wave == 0) {
                const int pp = lane >> 4, c = lane & 15; const LAS float* Ab = AM + (16 * pp) * 68 + 16 * pp;
                float acc[16];
#pragma unroll
                for (int i = 0; i < 16; ++i) acc[i] = (i == c) ? 1.f : 0.f;
#pragma unroll
                for (int j = 0; j < 15; ++j) { const float sj = acc[j];
#pragma unroll
                    for (int i = j + 1; i < 16; ++i) acc[i] -= Ab[i * 68 + j] * sj; }
#pragma unroll
                for (int i = 0; i < 16; ++i) TT[(16 * pp + i) * 68 + 16 * pp + c] = acc[i];
#pragma unroll
                for (int q = 0; q < 4; ++q) *(LAS f32x4*)(TC + (16 * pp + c) * 68 + 16 * pp + 4 * q) = (f32x4){acc[4 * q], acc[4 * q + 1], acc[4 * q + 2], acc[4 * q + 3]};
            } else if (wave < 5) {
#pragma unroll 2
                for (int f = (wave - 1) * 4; f < (wave - 1) * 4 + 4; ++f) { const int s = f & 1, t = (f >> 1) & 3, mi = f >> 3, i = 32 * mi + c31; const float sc = SCALE * __builtin_amdgcn_exp2f(gc[i]);
                    const LAS unsigned char* p = L + P_QB + i * PI_ST + (32 * t + 16 * s + 4 * hh) * 2; const v2u lo = *(const LAS v2u*)p, hi = *(const LAS v2u*)(p + 16);
                    v4u o; o.x = pg8::cvt_pk_bf16(bflo(lo.x) * sc, bfhi(lo.x) * sc); o.y = pg8::cvt_pk_bf16(bflo(lo.y) * sc, bfhi(lo.y) * sc); o.z = pg8::cvt_pk_bf16(bflo(hi.x) * sc, bfhi(hi.x) * sc); o.w = pg8::cvt_pk_bf16(bflo(hi.y) * sc, bfhi(hi.y) * sc);
                    st_wt16(rec + R_QDF(f) + lane * 16, o); }
            } else {
                const int f0 = (wave == 5) ? 0 : (wave == 6 ? 5 : 10), f1 = (wave == 5) ? 5 : (wave == 6 ? 10 : 16);
                for (int f = f0; f < f1; ++f) { const int s = f & 1, mi = (f >> 1) & 1, t = f >> 2, i0 = 32 * mi + 16 * s + 4 * hh;
                    const bf16x8 v = tr_frag(L + P_KB, i0, 8, 32 * t, lane); const v4u vw = __builtin_bit_cast(v4u, v);
                    const f32x4 ga = *(const LAS f32x4*)(gc + i0), gb = *(const LAS f32x4*)(gc + i0 + 8);
                    v4u o; o.x = pg8::cvt_pk_bf16(bflo(vw.x) * __builtin_amdgcn_exp2f(glast - ga[0]), bfhi(vw.x) * __builtin_amdgcn_exp2f(glast - ga[1]));
                    o.y = pg8::cvt_pk_bf16(bflo(vw.y) * __builtin_amdgcn_exp2f(glast - ga[2]), bfhi(vw.y) * __builtin_amdgcn_exp2f(glast - ga[3]));
                    o.z = pg8::cvt_pk_bf16(bflo(vw.z) * __builtin_amdgcn_exp2f(glast - gb[0]), bfhi(vw.z) * __builtin_amdgcn_exp2f(glast - gb[1]));
                    o.w = pg8::cvt_pk_bf16(bflo(vw.w) * __builtin_amdgcn_exp2f(glast - gb[2]), bfhi(vw.w) * __builtin_amdgcn_exp2f(glast - gb[3]));
                    st_wt16(rec + R_KT + f * 1024 + lane * 16, o); }
            }
            LDS_WAIT(); PREP_BAR();
            { const int pr = tid >> 8, i = (tid >> 4) & 15, c = tid & 15, p16 = 32 * pr + 16, q16 = 32 * pr;
              { const LAS float* ar = AM + (p16 + i) * 68 + q16; const LAS float* dc = TC + (q16 + c) * 68 + q16; float x = 0.f;
#pragma unroll
                for (int k4 = 0; k4 < 4; ++k4) { const f32x4 a = *(const LAS f32x4*)(ar + 4 * k4), d = *(const LAS f32x4*)(dc + 4 * k4); x += a[0] * d[0] + a[1] * d[1] + a[2] * d[2] + a[3] * d[3]; }
                XT[pr * 320 + c * 20 + i] = x; }
              LDS_WAIT(); PREP_BAR();
              { const LAS float* dr = TT + (p16 + i) * 68 + p16; const LAS float* xc = XT + pr * 320 + c * 20; float t = 0.f;
#pragma unroll
                for (int k4 = 0; k4 < 4; ++k4) { const f32x4 a = *(const LAS f32x4*)(dr + 4 * k4), d = *(const LAS f32x4*)(xc + 4 * k4); t -= a[0] * d[0] + a[1] * d[1] + a[2] * d[2] + a[3] * d[3]; }
                TT[(p16 + i) * 68 + q16 + c] = t; TC[(q16 + c) * 68 + p16 + i] = t; }
              LDS_WAIT(); PREP_BAR(); }
            { const int i = tid >> 4, c0 = 2 * (tid & 15);
              { const LAS float* ar = AM + (32 + i) * 68; const LAS float* t0 = TC + c0 * 68; const LAS float* t1 = t0 + 68; float y0 = 0.f, y1 = 0.f;
#pragma unroll
                for (int k4 = 0; k4 < 8; ++k4) { const f32x4 a = *(const LAS f32x4*)(ar + 4 * k4), d0 = *(const LAS f32x4*)(t0 + 4 * k4), d1 = *(const LAS f32x4*)(t1 + 4 * k4);
                    y0 += a[0] * d0[0] + a[1] * d0[1] + a[2] * d0[2] + a[3] * d0[3]; y1 += a[0] * d1[0] + a[1] * d1[1] + a[2] * d1[2] + a[3] * d1[3]; }
                YT[c0 * 36 + i] = y0; YT[(c0 + 1) * 36 + i] = y1; }
              LDS_WAIT(); PREP_BAR();
              { const LAS float* tr = TT + (32 + i) * 68 + 32; const LAS float* y0p = YT + c0 * 36; const LAS float* y1p = y0p + 36; float r0 = 0.f, r1 = 0.f;
#pragma unroll
                for (int k4 = 0; k4 < 8; ++k4) { const f32x4 a = *(const LAS f32x4*)(tr + 4 * k4), d0 = *(const LAS f32x4*)(y0p + 4 * k4), d1 = *(const LAS f32x4*)(y1p + 4 * k4);
                    r0 -= a[0] * d0[0] + a[1] * d0[1] + a[2] * d0[2] + a[3] * d0[3]; r1 -= a[0] * d1[0] + a[1] * d1[1] + a[2] * d1[2] + a[3] * d1[3]; }
                TT[(32 + i) * 68 + c0] = r0; TT[(32 + i) * 68 + c0 + 1] = r1; }
              LDS_WAIT(); PREP_BAR(); }
            }
            pre.have = false;
            if (PREP_PREFETCH) { const unsigned ni = bcn[0];
                if (ni < 2048u) { const int nh = ni & 3, nb = (ni >> 2) & 7, nn = ni >> 5, nt0 = nb * SEQ + nn * 64;
                    const float* bgp = (const float*)(F.ws + WS_BG) + (size_t)(nt0 + lane) * 8; pre.beta = bgp[nh]; pre.g = bgp[4 + nh];
#pragma unroll
                    for (int r = 0; r < 8; ++r) { const bf16* p = pa + ((size_t)((nb * 4 + nh) * SEQ + nn * 64 + wave * 8 + r)) * 384 + 2 * lane; pre.rq[r] = *(const unsigned*)p; pre.rk[r] = *(const unsigned*)(p + 128); pre.rv[r] = *(const unsigned*)(p + 256); }
                    pre.have = true; }
                else { pre.beta = 0.f; pre.g = 0.f;
#pragma unroll
                    for (int r = 0; r < 8; ++r) { pre.rq[r] = 0u; pre.rk[r] = 0u; pre.rv[r] = 0u; } } }
            for (int rp = 0; rp < PREPREP(4); ++rp) {
            {
                const int mi = wave & 1, sl = wave >> 1;
                f32x16 C;
#pragma unroll
                for (int r = 0; r < 16; ++r) C[r] = 0.f;
#pragma unroll
                for (int ks = 0; ks < 4; ++ks) { const LAS float* tp = TT + (32 * mi + c31) * 68 + 16 * ks + 8 * hh;
                    C = MFMA32(cvt8(*(const LAS f32x4*)tp, *(const LAS f32x4*)(tp + 4)), tr_frag(L + P_RV, 16 * ks + 8 * hh, 4, 32 * sl, lane), C); }
                unsigned char* up = rec + R_U + ((sl * 2 + mi) * 64 + lane) * 32;
                st_wt16(up, __builtin_bit_cast(v4u, pack8(C, 0))); st_wt16(up + 16, __builtin_bit_cast(v4u, pack8(C, 1)));
            }
            {
                const int t = wave & 3, mi = wave >> 2;
                f32x16 C;
#pragma unroll
                for (int r = 0; r < 16; ++r) C[r] = 0.f;
#pragma unroll
                for (int ks = 0; ks < 4; ++ks) { const LAS float* tp = TT + (32 * mi + c31) * 68 + 16 * ks + 8 * hh;
                    C = MFMA32(tr_frag(L + P_RK, 16 * ks + 8 * hh, 4, 32 * t, lane), cvt8(*(const LAS f32x4*)tp, *(const LAS f32x4*)(tp + 4)), C); }
#pragma unroll
                for (int r = 0; r < 16; ++r) C[r] = -C[r];
#pragma unroll
                for (int s = 0; s < 2; ++s) st_wt16(rec + R_WNF((mi * 4 + t) * 2 + s) + lane * 16, __builtin_bit_cast(v4u, pack8(C, s)));
            }
            }
            LDS_WAIT(); __syncthreads();
        }
        return (unsigned*)(F.ws + WS_CTL) + CW_RF + ((fl * 8 + b) * 4 + h) * 64 + n;
    }
}

constexpr int SC_OX = 8 * QTR, OXS = 136, OX_BYTES = 64 * OXS * 2;
__device__ __forceinline__ void gdn_out_rows(Frame& F, const LAS unsigned char* ox, int pw, int l, int h, size_t tok0, const v4u (&z)[2][4]) {
    const int lane = F.lane, q = lane & 3; bf16* y = (bf16*)(Y_BASE(F));
#pragma unroll
    for (int ps = 0; ps < 2; ++ps) { const int i = 32 * pw + 16 * ps + (lane >> 2);
        const LAS v4u* src = (const LAS v4u*)(ox + i * (OXS * 2) + q * 64); v4u o4[4]; float ss = 0.f;
#pragma unroll
        for (int k = 0; k < 4; ++k) { o4[k] = src[k];
            const float a0 = bflo(o4[k].x), a1 = bfhi(o4[k].x), a2 = bflo(o4[k].y), a3 = bfhi(o4[k].y), a4 = bflo(o4[k].z), a5 = bfhi(o4[k].z), a6 = bflo(o4[k].w), a7 = bfhi(o4[k].w);
            ss += (a0 * a0 + a1 * a1) + (a2 * a2 + a3 * a3) + (a4 * a4 + a5 * a5) + (a6 * a6 + a7 * a7); }
        ss += __shfl_xor(ss, 1); ss += __shfl_xor(ss, 2);
        const float rs = __builtin_amdgcn_rsqf(ss * (1.0f / 128.0f) + 1e-6f);
        bf16* yp = y + (tok0 + i) * 1024 + h * 128 + q * 32;
#pragma unroll
        for (int k = 0; k < 4; ++k) { const unsigned ow[4] = {o4[k].x, o4[k].y, o4[k].z, o4[k].w}; const unsigned zw[4] = {z[ps][k].x, z[ps][k].y, z[ps][k].z, z[ps][k].w}; unsigned rw[4];
#pragma unroll
            for (int e = 0; e < 4; ++e) rw[e] = pg8::cvt_pk_bf16(bflo(ow[e]) * rs * bflo(zw[e]), bfhi(ow[e]) * rs * bfhi(zw[e]));
            v4u r; r.x = rw[0]; r.y = rw[1]; r.z = rw[2]; r.w = rw[3]; *(v4u*)(yp + 8 * k) = r; }
    }
}
__device__ __forceinline__ void scan_wait_group(Frame& F, int l, int bh, int g) {
    unsigned* fp = (unsigned*)(F.ws + WS_CTL) + CW_RF + (l * 32 + bh) * 64 + g * 8 + (F.lane & 7);
    for (unsigned sp = 0; sp < (1u << 22); ++sp) { const unsigned v = __hip_atomic_load(fp, __ATOMIC_RELAXED, __HIP_MEMORY_SCOPE_AGENT); if (__ballot(v == 0u) == 0ull) break; __builtin_amdgcn_s_sleep(2); }
    __builtin_amdgcn_fence(__ATOMIC_ACQUIRE, "agent"); asm volatile("s_waitcnt vmcnt(0)" ::: "memory");
}
__device__ __forceinline__ void phase_gdn_scan(Frame& F, int l, int fl) {
    if (F.bid >= 32) return;
    const int b = F.bid >> 2, h = F.bid & 3, wave = F.wave, lane = F.lane;
    if (wave == 4) scan_wait_group(F, fl, b * 4 + h, 0);
    __syncthreads();
    const int rec0 = (b * 4 + h) * 64;
    const size_t tok00 = (size_t)b * SEQ;
    if (wave >= 6) {
        const int pw = wave - 6, q = lane & 3; const bf16* prest = (const bf16*)(F.ws + WS_Z);
#define SC_BAR() do { __builtin_amdgcn_s_barrier(); asm volatile("" ::: "memory"); } while (0)
        v4u zb[2][2][4];
#define SC_LOADZ(c, buf) do { _Pragma("unroll") for (int ps = 0; ps < 2; ++ps) { const v4u* zp = (const v4u*)(prest + (tok00 + (size_t)(c) * 64 + 32 * pw + 16 * ps + (lane >> 2)) * 512 + h * 128 + q * 32); \
            _Pragma("unroll") for (int k = 0; k < 4; ++k) zb[buf][ps][k] = zp[k]; } } while (0)
        SC_LOADZ(0, 0);
        __syncthreads();
        for (int n2 = 0; n2 < 64; n2 += 2) {
#pragma unroll
            for (int par = 0; par < 2; ++par) { const int n = n2 + par;
                if (n >= 1) gdn_out_rows(F, F.lds + SC_OX + ((n - 1) & 1) * OX_BYTES, pw, l, h, tok00 + (n - 1) * 64, zb[par ^ 1]);
                if (n + 1 < 64) SC_LOADZ(n + 1, par ^ 1);
                LDS_WAIT(); SC_BAR(); SC_BAR(); SC_BAR(); SC_BAR();
            }
        }
        gdn_out_rows(F, F.lds + SC_OX + (63 & 1) * OX_BYTES, pw, l, h, tok00 + 63 * 64, zb[1]);
#undef SC_LOADZ
    } else if (wave >= 4) {
        const int lw = wave - 4;
        auto issue = [&](int G) {
            const unsigned char* src = rec_ptr(F, rec0 + (G >> 2)) + (G & 3) * QTR + lw * 7168 + lane * 16; LAS unsigned char* dst = F.lds + (G & 7) * QTR + lw * 7168;
#pragma unroll
            for (int i = 0; i < 7; ++i) __builtin_amdgcn_global_load_lds((const unsigned*)(src + i * 1024), (LAS unsigned*)(dst + i * 1024), 16, 0, 0);
        };
        for (int G = 0; G < 7; ++G) issue(G);
        asm volatile("s_waitcnt vmcnt(42)" ::: "memory"); __builtin_amdgcn_s_barrier(); asm volatile("" ::: "memory");
        for (int G = 0; G < 256; ++G) {
            if (G + 7 < 256) issue(G + 7);
            if (lw == 0 && ((G + 12) & 31) == 0 && G + 12 < 256) scan_wait_group(F, fl, b * 4 + h, (G + 12) >> 5);
            const int left = 255 - G;
            if (left >= 7) asm volatile("s_waitcnt vmcnt(42)" ::: "memory");
            else if (left == 6) asm volatile("s_waitcnt vmcnt(35)" ::: "memory"); else if (left == 5) asm volatile("s_waitcnt vmcnt(28)" ::: "memory");
            else if (left == 4) asm volatile("s_waitcnt vmcnt(21)" ::: "memory"); else if (left == 3) asm volatile("s_waitcnt vmcnt(14)" ::: "memory");
            else if (left == 2) asm volatile("s_waitcnt vmcnt(7)" ::: "memory"); else asm volatile("s_waitcnt vmcnt(0)" ::: "memory");
            __builtin_amdgcn_s_barrier(); asm volatile("" ::: "memory");
        }
    } else {
        const int sl = wave, hh = lane >> 5, col = lane & 31;
        f32x16 S[4]; bf16x8 Sb[4][2];
#pragma unroll
        for (int t = 0; t < 4; ++t) {
#pragma unroll
            for (int r = 0; r < 16; ++r) S[t][r] = 0.f;
            Sb[t][0] = (bf16x8){0, 0, 0, 0, 0, 0, 0, 0}; Sb[t][1] = Sb[t][0]; }
        v4u U2[2][2][2];
#define SC_LOADU(c, buf) do { _Pragma("unroll") for (int mi = 0; mi < 2; ++mi) { const v4u* up = (const v4u*)(rec_ptr(F, rec0 + (c)) + R_U + ((sl * 2 + mi) * 64 + lane) * 32); U2[buf][mi][0] = up[0]; U2[buf][mi][1] = up[1]; } } while (0)
        SC_LOADU(0, 0); SC_LOADU(1, 1);
        __syncthreads();
        for (int n2 = 0; n2 < 64; n2 += 2) {
#pragma unroll
          for (int par = 0; par < 2; ++par) { const int n = n2 + par;
#ifdef SCAN_DELAY
            __builtin_amdgcn_s_sleep(SCAN_DELAY);
#endif
#define FRAG(fr) (*(const LAS bf16x8*)(F.lds + (((4 * n + (fr) / 14) & 7) * QTR) + ((fr) % 14) * 1024 + lane * 16))
            f32x16 Vp[2], O[2];
#pragma unroll
            for (int mi = 0; mi < 2; ++mi) {
#pragma unroll
                for (int g2 = 0; g2 < 2; ++g2) { const v4u u = U2[par][mi][g2];
                    Vp[mi][8 * g2 + 0] = bflo(u.x); Vp[mi][8 * g2 + 1] = bfhi(u.x); Vp[mi][8 * g2 + 2] = bflo(u.y); Vp[mi][8 * g2 + 3] = bfhi(u.y);
                    Vp[mi][8 * g2 + 4] = bflo(u.z); Vp[mi][8 * g2 + 5] = bfhi(u.z); Vp[mi][8 * g2 + 6] = bflo(u.w); Vp[mi][8 * g2 + 7] = bfhi(u.w); }
#pragma unroll
                for (int r = 0; r < 16; ++r) O[mi][r] = 0.f; }
            if (n + 2 < 64) SC_LOADU(n + 2, par);
#pragma unroll
            for (int pf = 0; pf < 16; ++pf) { const int mi = pf >> 3, t = (pf >> 1) & 3, s = pf & 1;
                const bf16x8 aw = FRAG(2 * pf), aq = FRAG(2 * pf + 1);
                Vp[mi] = MFMA32(aw, Sb[t][s], Vp[mi]); O[mi] = MFMA32(aq, Sb[t][s], O[mi]);
                if (pf == 6 || pf == 13) { LDS_WAIT(); SC_BAR(); } }
            bf16x8 Vb[2][2];
#pragma unroll
            for (int mi = 0; mi < 2; ++mi) { Vb[mi][0] = pack8(Vp[mi], 0); Vb[mi][1] = pack8(Vp[mi], 1); }
#pragma unroll
            for (int mo = 0; mo < 2; ++mo)
#pragma unroll
                for (int mi = 0; mi <= mo; ++mi)
#pragma unroll
                    for (int s = 0; s < 2; ++s) { const bf16x8 a = FRAG(32 + (mo * 2 + mi) * 2 + s); O[mo] = MFMA32(a, Vb[mi][s], O[mo]); }
            const float dl = *(const LAS float*)(F.lds + (((4 * n + 2) & 7) * QTR) + (34 - 28) * 1024);
#pragma unroll
            for (int t = 0; t < 4; ++t) {
#pragma unroll
                for (int r = 0; r < 16; ++r) S[t][r] *= dl;
#pragma unroll
                for (int mi = 0; mi < 2; ++mi)
#pragma unroll
                    for (int s = 0; s < 2; ++s) { const int kf = (t * 2 + mi) * 2 + s; const bf16x8 a = FRAG(40 + kf); S[t] = MFMA32(a, Vb[mi][s], S[t]);
                        if (kf == 1) { LDS_WAIT(); SC_BAR(); } }
                Sb[t][0] = pack8(S[t], 0); Sb[t][1] = pack8(S[t], 1); }
#undef FRAG
            LAS bf16* ox = (LAS bf16*)(F.lds + SC_OX + (n & 1) * OX_BYTES);
#pragma unroll
            for (int mo = 0; mo < 2; ++mo)
#pragma unroll
                for (int r = 0; r < 16; ++r) ox[(32 * mo + (r & 3) + 8 * (r >> 2) + 4 * hh) * OXS + 32 * sl + col] = (bf16)(pg8::cvt_pk_bf16(O[mo][r], 0.f) & 0xffffu);
            LDS_WAIT(); SC_BAR();
          }
        }
#undef SC_LOADU
#undef SC_BAR
    }
}
constexpr int AT_OS = 0, AT_OSTRIDE = 136, AT_M = 512 * AT_OSTRIDE + 128  , AT_L = AT_M + 2048, AT_V = AT_L + 2048, AT_VROW = 144, AT_VBYTES = 32 * AT_VROW, AT_BC = AT_V + 16 * AT_VBYTES;
#ifndef MIX_REP_SHIFT_P
#define MIX_REP_SHIFT_P 0
#endif
#ifndef MIX_REP_SHIFT_A
#define MIX_REP_SHIFT_A 0
#endif
#ifndef MIX_REP_PREP
#define MIX_REP_PREP 0
#endif
#ifndef MIX_DENSE_MODE
#define MIX_DENSE_MODE 0
#endif
#ifndef MIX_DENSE_NOBAR
#define MIX_DENSE_NOBAR false
#endif
#ifndef MIX_DENSE_LO
#define MIX_DENSE_LO 0
#endif
#ifndef MIX_DENSE_HI
#define MIX_DENSE_HI 3
#endif
#ifndef MIX_REP_ATTN
#define MIX_REP_ATTN 0
#endif
constexpr int CW_ATTN = 8192;

template <int MODE = 0>
__device__ __forceinline__ void attn_qtile(Frame& F, int cfg, int d, int rr, int i0, int b, int h, int P0, float c2, int nd, int nrr, int ni0) {
#ifdef ATTN_NO_OPAQUE
    const int lane = F.lane, qi = lane & 31, hh = lane >> 5;
#else
    int lane_o = F.lane; asm volatile("" : "+v"(lane_o));
    const int lane = lane_o, qi = lane & 31, hh = lane >> 5;
#endif
    const bf16* qkv = (const bf16*)(F.ws + WS_QKV) + (size_t)(b * 8 + h) * SEQ * 192;
    const size_t tokb = (size_t)b * SEQ;
    const int qpos = (i0 + qi) * d + rr;
    bf16x8 Qf[4];
    {
        LAS unsigned char* qimg = F.lds + AT_V + F.wave * 2 * AT_VBYTES;
#pragma unroll
        for (int i = 0; i < 4; ++i) { const int qrow = (lane >> 3) + 8 * i;
            *(LAS bf16x8*)(qimg + qrow * AT_VROW + 16 * (lane & 7)) = *(const bf16x8*)((const char*)qkv + (unsigned)(((i0 + qrow) * d + rr) * 384 + 16 * (lane & 7))); }
#pragma unroll
        for (int ks = 0; ks < 4; ++ks) Qf[ks] = *(const LAS bf16x8*)(qimg + qi * AT_VROW + (16 * ks + 8 * hh) * 2);
    }
    float m = -1e30f, lsum = 0.f; f32x16 OT[2];
#pragma unroll
    for (int r = 0; r < 16; ++r) { OT[0][r] = 0.f; OT[1][r] = 0.f; }
    const int base = i0 - 128, kt_lo = base < 0 ? (-base) >> 5 : 0;
    const float c1 = 0.125f * 1.44269504089f;
    LAS unsigned char* vb0 = F.lds + AT_V + F.wave * 2 * AT_VBYTES;
    bf16x8 KB3[3][4]; v4u VB3[3][4];
#define AT_KT(q) (4 - (q))
#define AT_LOADK(q) do { const int kk_ = AT_KT(q) < kt_lo ? kt_lo : AT_KT(q); \
        _Pragma("unroll") for (int i = 0; i < 4; ++i) { const int key_ = (lane >> 3) + 8 * i; \
            KB3[(q) % 3][i] = *(const bf16x8*)((const char*)qkv + (unsigned)(((base + 32 * kk_ + key_) * d + rr) * 384 + 128 + 16 * (lane & 7))); } } while (0)
#define AT_LOADV(q) do { const int kk_ = AT_KT(q) < kt_lo ? kt_lo : AT_KT(q); \
        _Pragma("unroll") for (int i = 0; i < 4; ++i) { const int key_ = (lane >> 3) + 8 * i; \
            VB3[(q) % 3][i] = *(const v4u*)((const char*)qkv + (unsigned)(((base + 32 * kk_ + key_) * d + rr) * 384 + 256 + 16 * (lane & 7))); } } while (0)
#define AT_QK(q, dst) do { _Pragma("unroll") for (int r = 0; r < 16; ++r) dst[r] = 0.f; \
        _Pragma("unroll") for (int i = 0; i < 4; ++i) *(LAS bf16x8*)(vb0 + ((lane >> 3) + 8 * i) * AT_VROW + 16 * (lane & 7)) = KB3[(q) % 3][i]; \
        if (MODE < 3) { _Pragma("unroll") for (int ks = 0; ks < 4; ++ks) dst = MFMA32(*(const LAS bf16x8*)(vb0 + qi * AT_VROW + (16 * ks + 8 * hh) * 2), Qf[ks], dst); } \
        else { _Pragma("unroll") for (int ks = 0; ks < 4; ++ks) asm volatile("" :: "v"(KB3[(q) % 3][ks])); } } while (0)
#define AT_SOFTPV(q, ST) do { \
        if (MODE >= 2) { _Pragma("unroll") for (int i = 0; i < 4; ++i) asm volatile("" :: "v"(VB3[(q) % 3][i])); if (MODE == 2) { _Pragma("unroll") for (int r = 0; r < 16; ++r) OT[0][r] += ST[r]; } break; } \
        LAS unsigned char* vb = vb0 + AT_VBYTES; \
        _Pragma("unroll") for (int i = 0; i < 4; ++i) *(LAS v4u*)(vb + ((lane >> 3) + 8 * i) * AT_VROW + 16 * (lane & 7)) = VB3[(q) % 3][i]; \
        const float hh4_ = (AT_KT(q) >= kt_lo) ? hh4 : -INFINITY; \
        float mx_[4] = {-INFINITY, -INFINITY, -INFINITY, -INFINITY}; \
        _Pragma("unroll") for (int r = 0; r < 16; ++r) { const int rowoff = (r & 3) + 8 * (r >> 2); \
            float t = __builtin_fmaf(ST[r], c1c2, hh4_) + (float)(32 * AT_KT(q) + rowoff); \
            if (AT_KT(q) == 0) t = (rowoff + 4 * hh >= qi) ? t : -INFINITY; \
            if (AT_KT(q) == 4) t = (rowoff + 4 * hh <= qi) ? t : -INFINITY; \
            ST[r] = t; mx_[r & 3] = fmaxf(mx_[r & 3], t); } \
        f32x16 P_; \
        if (MODE == 1) { _Pragma("unroll") for (int r = 0; r < 16; ++r) P_[r] = ST[r]; } else \
        if ((q) == 0) { float tmax = fmaxf(fmaxf(mx_[0], mx_[1]), fmaxf(mx_[2], mx_[3])); tmax = fmaxf(tmax, __shfl_xor(tmax, 32)); m = tmax; nm = -c2 * m; \
            _Pragma("unroll") for (int r = 0; r < 16; ++r) P_[r] = __builtin_amdgcn_exp2f(__builtin_fmaf(ST[r], c2, nm)); } \
        else { \
            _Pragma("unroll") for (int r = 0; r < 16; ++r) P_[r] = __builtin_amdgcn_exp2f(__builtin_fmaf(ST[r], c2, nm)); \
            float tmax = fmaxf(fmaxf(mx_[0], mx_[1]), fmaxf(mx_[2], mx_[3])); tmax = fmaxf(tmax, __shfl_xor(tmax, 32)); \
            if (__ballot(tmax > m + thr) != 0ull) { const float mnew = fmaxf(m, tmax), corr = __builtin_amdgcn_exp2f(c2 * (m - mnew)); m = mnew; nm = -c2 * m; lsum *= corr; \
                _Pragma("unroll") for (int r = 0; r < 16; ++r) { OT[0][r] *= corr; OT[1][r] *= corr; P_[r] = __builtin_amdgcn_exp2f(__builtin_fmaf(ST[r], c2, nm)); } } } \
        float ps_[4] = {0.f, 0.f, 0.f, 0.f}; \
        _Pragma("unroll") for (int r = 0; r < 16; ++r) ps_[r & 3] += P_[r]; \
        lsum += (ps_[0] + ps_[1]) + (ps_[2] + ps_[3]); \
        const bf16x8 Pb0 = pack8(P_, 0), Pb1 = pack8(P_, 1); \
        _Pragma("unroll") for (int dvt = 0; dvt < 2; ++dvt) \
            _Pragma("unroll") for (int s = 0; s < 2; ++s) { \
                const int col = 32 * dvt + 16 * ((lane >> 4) & 1) + 4 * (lane & 3), key0 = 16 * s + 4 * hh + ((lane & 15) >> 2); \
                const s16x4 lo = __builtin_amdgcn_ds_read_tr16_b64_v4i16((LAS s16x4*)(vb + key0 * AT_VROW + col * 2)); \
                const s16x4 hi = __builtin_amdgcn_ds_read_tr16_b64_v4i16((LAS s16x4*)(vb + (key0 + 8) * AT_VROW + col * 2)); \
                const bf16x8 vt = {lo[0], lo[1], lo[2], lo[3], hi[0], hi[1], hi[2], hi[3]}; \
                OT[dvt] = MFMA32(vt, s == 0 ? Pb0 : Pb1, OT[dvt]); } } while (0)
    const float hh4 = (float)(4 * hh), c1c2 = c1 / c2, thr = 8.0f / c2; float nm = 0.f;
    f32x16 SA, SB;
    AT_LOADK(0); AT_LOADK(1); AT_LOADV(0); AT_LOADK(2); AT_LOADV(1);
#define AT_OK(q) (MODE != 0 || AT_KT(q) >= kt_lo)
    AT_QK(0, SA);
    if (AT_OK(1)) AT_QK(1, SB); AT_LOADK(3); AT_LOADV(2); AT_SOFTPV(0, SA);
    if (AT_OK(2)) AT_QK(2, SA); AT_LOADK(4); AT_LOADV(3); if (AT_OK(1)) AT_SOFTPV(1, SB);
    if (AT_OK(3)) AT_QK(3, SB);              AT_LOADV(4); if (AT_OK(2)) AT_SOFTPV(2, SA);
    if (AT_OK(4)) AT_QK(4, SA);                           if (AT_OK(3)) AT_SOFTPV(3, SB);
                                                          if (AT_OK(4)) AT_SOFTPV(4, SA);
#undef AT_OK
#undef AT_KT
#undef AT_LOADK
#undef AT_LOADV
#undef AT_QK
#undef AT_SOFTPV
    m = c2 * (m - (float)(qi + 128));
    const float ltot = lsum + __shfl_xor(lsum, 32);
    const int slot = qpos - P0;
    LAS float* Ms = (LAS float*)(F.lds + AT_M); LAS float* Ls = (LAS float*)(F.lds + AT_L);
    LAS unsigned char* os = F.lds + AT_OS + slot * AT_OSTRIDE + ((slot >> 5) & 15) * 8;
    if (cfg == 0) {
        if (hh == 0) { Ms[slot] = m; Ls[slot] = ltot; }
#pragma unroll
        for (int dvt = 0; dvt < 2; ++dvt)
#pragma unroll
            for (int g = 0; g < 4; ++g) { v2u w; w.x = pg8::cvt_pk_bf16(OT[dvt][4 * g], OT[dvt][4 * g + 1]); w.y = pg8::cvt_pk_bf16(OT[dvt][4 * g + 2], OT[dvt][4 * g + 3]);
                *(LAS v2u*)(os + (32 * dvt + 8 * g + 4 * hh) * 2) = w; }
    } else {
        const float m0 = Ms[slot], l0 = Ls[slot], mn = fmaxf(m, m0), a = __builtin_amdgcn_exp2f(m - mn), b0 = __builtin_amdgcn_exp2f(m0 - mn), ln = ltot * a + l0 * b0;
        const float inv = (cfg == 2) ? 1.0f / ln : 1.0f;
#pragma unroll
        for (int dvt = 0; dvt < 2; ++dvt)
#pragma unroll
            for (int g = 0; g < 4; ++g) { const int dv0 = 32 * dvt + 8 * g + 4 * hh; const v2u o = *(const LAS v2u*)(os + dv0 * 2);
                const float e0 = (OT[dvt][4 * g] * a + bflo(o.x) * b0) * inv, e1 = (OT[dvt][4 * g + 1] * a + bfhi(o.x) * b0) * inv,
                            e2 = (OT[dvt][4 * g + 2] * a + bflo(o.y) * b0) * inv, e3 = (OT[dvt][4 * g + 3] * a + bfhi(o.y) * b0) * inv;
                v2u w; w.x = pg8::cvt_pk_bf16(e0, e1); w.y = pg8::cvt_pk_bf16(e2, e3);
                if (cfg == 2) *(LAS v2u*)(vb0 + qi * AT_VROW + dv0 * 2) = w; else *(LAS v2u*)(os + dv0 * 2) = w; }
        if (cfg == 1 && hh == 0) { Ms[slot] = mn; Ls[slot] = ln; }
        if (cfg == 2) {
#pragma unroll
            for (int i = 0; i < 4; ++i) { const int row = (lane >> 3) + 8 * i;
                *(v4u*)((bf16*)(Y_BASE(F)) + (tokb + (size_t)((i0 + row) * d + rr)) * 1024 + 512 + h * 64 + 8 * (lane & 7)) = *(const LAS v4u*)(vb0 + row * AT_VROW + 16 * (lane & 7)); } }
    }
}
template <int CFG, bool NOBAR = false, int MODE = 0>
__device__ __forceinline__ void attn_cfg(Frame& F, int b, int h, int P0, float slope_l2e) {
    constexpr int d = (CFG == 0) ? 16 : (CFG == 1 ? 4 : 1);
#pragma unroll 1
    for (int tt = 0; tt < 2; ++tt) { const int Tq = 2 * F.wave + tt;
        const int rr = (CFG == 0) ? Tq : (CFG == 1 ? (Tq >> 2) : 0), t = (CFG == 0) ? 0 : (CFG == 1 ? (Tq & 3) : Tq);
        attn_qtile<MODE>(F, CFG, d, rr, P0 / d + 32 * t, b, h, P0, slope_l2e * (float)d, 0, 0, 0); }
    if (!NOBAR) { LDS_WAIT(); __syncthreads(); }
}
template <int CFG_LO = 0, int CFG_HI = 3, bool NOBAR = false, int MODE = 0>
__device__ __forceinline__ void attn_item(Frame& F, unsigned item) {
    const int b = item >> 6, h = (item >> 3) & 7, P0 = (int)(item & 7) * 512;
    const float slope_l2e = exp2f(-(float)(h + 1)) * 1.44269504089f;
    if (CFG_LO <= 0 && 0 < CFG_HI) attn_cfg<0, NOBAR, MODE>(F, b, h, P0, slope_l2e);
    if (CFG_LO <= 1 && 1 < CFG_HI) attn_cfg<1, NOBAR, MODE>(F, b, h, P0, slope_l2e);
    if (CFG_LO <= 2 && 2 < CFG_HI) attn_cfg<2, NOBAR, MODE>(F, b, h, P0, slope_l2e);
}
__device__ __forceinline__ void phase_mixer(Frame& F, int l, const pg8::ssq_t* sumsq, int qslot) {
#ifdef PROBE_TL
    const unsigned long long tl0 = wall_clock64(); unsigned long long tld = 0; bool tl_seen = false;
#endif
    phase_gdn_scan(F, l, qslot);
#ifdef PROBE_TL
    if (PROBE_TL == 2 && F.bid == 0) tld = wall_clock64() - tl0;
#endif
    unsigned* ctr = (unsigned*)(F.ws + WS_CTL) + CW_ATTN + 64 * qslot;
    volatile LAS unsigned* bc = (volatile LAS unsigned*)(F.lds + LDSCTL_OFF + 64);
    {
        PrepPre pre; pre.have = false; pre.beta = 0.f; pre.g = 0.f;
#pragma unroll
        for (int r = 0; r < 8; ++r) { pre.rq[r] = 0u; pre.rk[r] = 0u; pre.rv[r] = 0u; }
        unsigned* pend = nullptr;
        __syncthreads();
        if (F.tid == 0) bc[0] = atomicAdd(ctr, 1u);
        for (int it = 0;; ++it) {
            __syncthreads();
            const unsigned item = bc[it & 1];
            unsigned nxt = 0u; if (F.tid == 0 && item < 2048u) nxt = atomicAdd(ctr, 1u);
            if (item >= 2048u) break;
            pend = gdn_prep_item(F, l, sumsq, (int)item, qslot, pend, pre, bc + 2, nxt);
            if (F.tid == 0) bc[(it + 1) & 1] = nxt;
        }
        if (pend) { VM_WAIT(); __syncthreads(); if (F.tid == 0) __hip_atomic_store(pend, 1u, __ATOMIC_RELAXED, __HIP_MEMORY_SCOPE_AGENT); }
    }
#ifdef PROBE_TL
    if (PROBE_TL == 1 && F.bid == 32) tld = wall_clock64() - tl0;
#endif
    for (int k = 0; k < 8; ++k) { const unsigned q = (unsigned)(F.bid + k) & 7u;
        for (;;) {
            __syncthreads(); if (F.tid == 0) bc[0] = atomicAdd(ctr + 32 + q, 1u); __syncthreads();
            const unsigned jx = bc[0]; if (jx >= 64u) break;
            for (int rp = 0; rp < 1 + MIX_REP_ATTN; ++rp) attn_item(F, (((q << 6) | jx) + (unsigned)rp * MIX_REP_SHIFT_A) & 511u); } }
#ifdef PROBE_TL
    if ((PROBE_TL == 3 && F.bid == 32) || (PROBE_TL == 4 && F.bid == 0)) tld = wall_clock64() - tl0;
    if (tld) { const unsigned long long t1 = wall_clock64(); while (wall_clock64() - t1 < tld) __builtin_amdgcn_s_sleep(8); }
#endif
#ifdef MIX_DENSE_ATTN
    for (int dr = 0; dr < MIX_DENSE_ATTN; ++dr) { unsigned* c2 = ctr + 16 + 8 * dr;
      for (;;) { __syncthreads(); if (F.tid == 0) bc[0] = atomicAdd(c2, 1u); __syncthreads(); const unsigned item = bc[0]; if (item >= 512u) break; attn_item<MIX_DENSE_LO, MIX_DENSE_HI, MIX_DENSE_NOBAR, MIX_DENSE_MODE>(F, item); } }
#endif
}
__device__ __forceinline__ void phase_fixup(Frame& F, int l) {
    const float* hf = (const float*)(F.ws + WS_HFIRST); const float* uf = (const float*)(F.ws + WS_UFIRST); const float* hl = (const float*)(F.ws + WS_HLAST);
    const float* cw = F.ffn_conv + (size_t)l * 3 * DFF; bf16* act = (bf16*)(F.ws + WS_ACT);
    constexpr int NE = 128 * 2 * DFF; const int stride = F.G * NTHREADS;
    for (int i0 = F.bid * NTHREADS + F.tid; i0 < NE; i0 += 6 * stride) {
    float g0[6], g1[6], gm1[6], gm2[6], u0[6], w0[6], w1[6], w2[6];
#pragma unroll
    for (int q = 0; q < 6; ++q) { const int i = i0 + q * stride; const bool ok = i < NE; const int ii = ok ? i : 0;
        const int pm = ii / (2 * DFF), r = (ii / DFF) & 1, c = ii % DFF; const bool halo = (pm % 16) != 0; const int pmm = halo ? pm - 1 : pm;
        g0[q] = hf[((size_t)pm * 2 + 0) * DFF + c]; g1[q] = hf[((size_t)pm * 2 + 1) * DFF + c];
        gm1[q] = hl[((size_t)pmm * 2 + 1) * DFF + c]; gm2[q] = hl[((size_t)pmm * 2 + 0) * DFF + c]; if (!halo) { gm1[q] = 0.f; gm2[q] = 0.f; }
        u0[q] = uf[((size_t)pm * 2 + r) * DFF + c]; w0[q] = cw[c]; w1[q] = cw[DFF + c]; w2[q] = cw[2 * DFF + c]; }
    asm volatile("" ::: "memory");
#pragma unroll
    for (int q = 0; q < 6; ++q) { const int i = i0 + q * stride; if (i < NE) { const int pm = i / (2 * DFF), r = (i / DFF) & 1, c = i % DFF;
        const float cv = (r == 0) ? (w0[q] * gm2[q] + w1[q] * gm1[q] + w2[q] * g0[q]) : (w0[q] * gm1[q] + w1[q] * g0[q] + w2[q] * g1[q]);
        act[(size_t)(pm * 256 + r) * DFF + c] = (bf16)f2bf(silu_acc(cv) * u0[q]); } }
    }
}
__device__ __forceinline__ void fixup_panel(Frame& F, int l, int pm) {
    const float* hf = (const float*)(F.ws + WS_HFIRST); const float* uf = (const float*)(F.ws + WS_UFIRST); const float* hl = (const float*)(F.ws + WS_HLAST);
    const float* cw = F.ffn_conv + (size_t)l * 3 * DFF; bf16* act = (bf16*)(F.ws + WS_ACT);
    const bool halo = (pm % 16) != 0; const int pmm = halo ? pm - 1 : pm;
#pragma unroll 1
    for (int q0 = 0; q0 < 11; q0 += 6) {
        float g0[6], g1[6], gm1[6], gm2[6], u0[6], w0[6], w1[6], w2[6];
#pragma unroll
        for (int q = 0; q < 6; ++q) { const int i = F.tid + (q0 + q < 11 ? q0 + q : 10) * NTHREADS; const int r = i / DFF, c = i % DFF;
            g0[q] = hf[((size_t)pm * 2 + 0) * DFF + c]; g1[q] = hf[((size_t)pm * 2 + 1) * DFF + c];
            gm1[q] = hl[((size_t)pmm * 2 + 1) * DFF + c]; gm2[q] = hl[((size_t)pmm * 2 + 0) * DFF + c]; if (!halo) { gm1[q] = 0.f; gm2[q] = 0.f; }
            u0[q] = uf[((size_t)pm * 2 + r) * DFF + c]; w0[q] = cw[c]; w1[q] = cw[DFF + c]; w2[q] = cw[2 * DFF + c]; }
        asm volatile("" ::: "memory");
#pragma unroll
        for (int q = 0; q < 6; ++q) if (q0 + q < 11) { const int i = F.tid + (q0 + q) * NTHREADS; const int r = i / DFF, c = i % DFF;
            const float cv = (r == 0) ? (w0[q] * gm2[q] + w1[q] * gm1[q] + w2[q] * g0[q]) : (w0[q] * gm1[q] + w1[q] * g0[q] + w2[q] * g1[q]);
            act[(size_t)(pm * 256 + r) * DFF + c] = (bf16)f2bf(silu_acc(cv) * u0[q]); }
    }
}
static_assert(11 * NTHREADS == 2 * DFF, "fixup_panel covers 2 x DFF elements with 11 per thread");
__device__ __forceinline__ void phase_final(Frame& F, const pg8::ssq_t* sumsq) {
    const int gw = F.bid * NWAVES + F.wave, NGW = F.G * NWAVES;
    const f32x4* g4 = (const f32x4*)F.ln_f + F.lane;
    f32x4 g[4];
#pragma unroll
    for (int j = 0; j < 4; ++j) g[j] = g4[64 * j];
    for (int m0 = gw * 4; m0 < T; m0 += NGW * 4) {
        uint2 v[4][4]; float rs[4];
#pragma unroll
        for (int r = 0; r < 4; ++r) { const uint2* xr = (const uint2*)((const bf16*)(F.ws + WS_XB) + (size_t)(m0 + r) * DM) + F.lane; rs[r] = __builtin_amdgcn_rsqf(pg8::ssq_val(sumsq[m0 + r]) * (1.0f / 1024.0f) + 1e-6f);
#pragma unroll
            for (int j = 0; j < 4; ++j) v[r][j] = xr[64 * j]; }
#pragma unroll
        for (int r = 0; r < 4; ++r) { f32x4* xr = (f32x4*)(F.out + (size_t)(m0 + r) * DM) + F.lane;
#pragma unroll
            for (int j = 0; j < 4; ++j) { const uint2 q = v[r][j];
                const f32x4 x4 = {__builtin_bit_cast(float, q.x << 16), __builtin_bit_cast(float, q.x & 0xffff0000u), __builtin_bit_cast(float, q.y << 16), __builtin_bit_cast(float, q.y & 0xffff0000u)};
                xr[64 * j] = x4 * rs[r] * g[j]; } }
    }
}

__global__ void __launch_bounds__(NTHREADS, 2) mk_fwd(Args args) {
    extern __shared__ __attribute__((aligned(16))) unsigned char lds[];
    Frame F;
    F.lds = (LAS unsigned char*)lds;
    const int wave0 = __builtin_amdgcn_readfirstlane(threadIdx.x >> 6);
    F.tid = threadIdx.x; F.lane = F.tid & 63; F.wave = wave0; F.G = gridDim.x; F.bid = blockIdx.x;
    F.x = args.in[0]; F.ln1 = args.in[1]; F.w_in = args.in[2]; F.conv_qkv = args.in[3]; F.a_log = args.in[4]; F.dt_bias = args.in[5]; F.gdn_norm = args.in[6];
    F.w_out = args.in[7]; F.ln2 = args.in[8]; F.w_gate = args.in[9]; F.w_up = args.in[10]; F.ffn_conv = args.in[11]; F.w_down = args.in[12]; F.ln_f = args.in[13];
    F.out = args.out; F.ws = args.ws;
    volatile LAS unsigned* MISC = (volatile LAS unsigned*)(F.lds + MISC_OFF);
    for (int u = F.tid; u < (LDS_BYTES - LDSCTL_OFF) / 4; u += NTHREADS) ((LAS unsigned*)(F.lds + LDSCTL_OFF))[u] = 0u;
    __syncthreads();
    unsigned* ctl = (unsigned*)(F.ws + WS_CTL);
#if !MK_SPLIT
    XcdBarrier bar = xcd_barrier_post(ctl + CW_BAR, MISC + 8);
#endif
    const int lo = args.ph_lo, hi = args.ph_hi;
    pg8::ssq_t* sumsq = (pg8::ssq_t*)(F.ws + WS_SUMSQ);
    int seam = 0;
#if MK_SPLIT
#define SEAM() do { } while (0)
#else
#ifndef SEAM_REP
#define SEAM_REP 0
#endif
#ifndef SEAM_CG
#define SEAM_CG 0
#endif
#define SEAM() do { if (SEAM_CG && seam == 0) { cg::this_grid().sync(); } else { xcd_barrier(bar); for (int sr_ = 0; sr_ < SEAM_REP; ++sr_) xcd_barrier(bar); } ++seam; } while (0)
#endif
#define REFRESH() do { int ln_ = (int)__builtin_amdgcn_mbcnt_hi(~0u, __builtin_amdgcn_mbcnt_lo(~0u, 0u)); asm volatile("" : "+v"(ln_)); int w_ = wave0; asm volatile("" : "+s"(w_)); F.lane = ln_; F.wave = w_; F.tid = w_ * 64 + ln_; } while (0)
#define IN(k) (lo <= (k) && (k) < hi)
#define BOTH(k) (IN(k) && IN((k) + 1))
#ifndef PH_MASK
#define PH_MASK 0xff
#endif
#ifndef ALIGN_RESID
#define ALIGN_RESID true
#endif
#ifndef ALIGN_PLAIN
#define ALIGN_PLAIN true
#endif
#ifndef REP_PHASE
#define REP_PHASE -1
#endif
#ifndef REP_N
#define REP_N 0
#endif
#define NREP(id) (1 + ((REP_PHASE) == (id) ? (REP_N) : 0))
    if ((PH_MASK & 1) && IN(0)) { for (int rep = 0; rep < NREP(0); ++rep) { REFRESH(); phase_p0(F); }

#if !MK_SPLIT
        __syncthreads(); xcd_census(bar);
#endif
        if (BOTH(0)) SEAM(); }
    for (int l = 0; l < DEPTH; ++l) {
        const int pb = 1 + 6 * l;
        const pg8::ssq_t* ss1 = sumsq + (size_t)(2 * l) * T;
        pg8::ssq_t* ss2 = sumsq + (size_t)(2 * l + 1) * T;
        pg8::ssq_t* ss3 = sumsq + (size_t)(2 * l + 2) * T;
        if ((PH_MASK & 2) && IN(pb + 0)) {
            REFRESH();
            pg8::Gemm g{(const bf16*)(F.ws + WS_XB), (const bf16*)(F.ws + WS_WIN) + (size_t)l * NIN * DM, T, NIN, DM}; pg8::StaticOrder S; S.init(T, NIN, F.G, F.bid);
            pg8::EpiProj E{(bf16*)(F.ws + WS_PA), 1536, (bf16*)(F.ws + WS_Z), (bf16*)(F.ws + WS_QKV), 6, ss1, F.gdn_norm + l * 128, (const PG8_LAS float*)(F.lds + pg8::SIDE_OFF),
                            F.conv_qkv + (size_t)l * 4 * 1536, (float*)(F.ws + WS_QFIRST), (float*)(F.ws + WS_QLAST), (PG8_LAS pg8::f32x4*)(F.lds + XL_OFF), 0, (unsigned char*)F.out};
#ifdef PROBE_NULL_REP
            for (int rep = 0; rep < NREP(1); ++rep) { E.skip = (rep + 1 < NREP(1)); pg8::gemm_phase<pg8::EpiProj, pg8::StaticOrder, ALIGN_PLAIN, PG8_SP2>(F.lds + RING_OFF, g, S, E, F.tid); }
#else
            for (int rep = 0; rep < NREP(1); ++rep) pg8::gemm_phase<pg8::EpiProj, pg8::StaticOrder, ALIGN_PLAIN, PG8_SP2>(F.lds + RING_OFF, g, S, E, F.tid);
#endif
#ifdef PROBE_NULL_GEMM
            for (int rep = 0; rep < PROBE_NULL_GEMM; ++rep) { pg8::EpiNull En; pg8::gemm_phase<pg8::EpiNull, pg8::StaticOrder, true, PG8_SP2>(F.lds + RING_OFF, g, S, En, F.tid); }
#endif
            REFRESH(); logits_phase(F, l, ss1);
            if (BOTH(pb + 0)) SEAM();
        }
        if ((PH_MASK & 8) && IN(pb + 1)) { for (int rep = 0; rep < NREP(3); ++rep) { REFRESH(); phase_mixer(F, l, ss1, l + 2 * rep); } if (BOTH(pb + 1)) SEAM(); }
        if ((PH_MASK & 16) && IN(pb + 2)) {
            REFRESH();
            pg8::Gemm g{(const bf16*)(Y_BASE(F)), (const bf16*)(F.ws + WS_WOUT) + (size_t)l * DM * DM, T, DM, DM}; pg8::StaticOrder S; S.init(T, DM, F.G, F.bid);
            pg8::EpiResid E{(bf16*)(F.ws + WS_XB), ss2};
            pg8::gemm_phase<pg8::EpiResid, pg8::StaticOrder, ALIGN_RESID, PG8_SP2>(F.lds + RING_OFF, g, S, E, F.tid);
            if (BOTH(pb + 2)) SEAM();
        }
        if ((PH_MASK & 32) && IN(pb + 3)) {
            REFRESH();
            pg8::Gemm g{(const bf16*)(F.ws + WS_XB), (const bf16*)(F.ws + WS_WGU) + (size_t)l * NGU * DM, T, NGU, DM}; pg8::StaticOrder S; S.init(T, NGU, F.G, F.bid);
            pg8::EpiGateUp E{(bf16*)(F.ws + WS_ACT), ss2, F.ffn_conv + (size_t)l * 3 * DFF, (float*)(F.ws + WS_HFIRST), (float*)(F.ws + WS_UFIRST), (float*)(F.ws + WS_HLAST), (PG8_LAS pg8::f32x4*)(F.lds + XL_OFF), (const PG8_LAS float*)(F.lds + pg8::SIDE_OFF)};
            for (int rep = 0; rep < NREP(5); ++rep) pg8::gemm_phase<pg8::EpiGateUp, pg8::StaticOrder, true, PG8_SP2>(F.lds + RING_OFF, g, S, E, F.tid);
            if (BOTH(pb + 3)) SEAM();
        }
#ifndef MERGE_FIXUP
#define MERGE_FIXUP 1
#endif
        if (!MERGE_FIXUP && (PH_MASK & 64) && IN(pb + 4)) { REFRESH(); phase_fixup(F, l); if (BOTH(pb + 4)) SEAM(); }
        if ((PH_MASK & 128) && IN(pb + 5)) {
            REFRESH();
            pg8::Gemm g{(const bf16*)(F.ws + WS_ACT), (const bf16*)(F.ws + WS_WD) + (size_t)l * DM * DFF, T, DM, DFF}; pg8::StaticOrder S; S.init(T, DM, F.G, F.bid);
            if (MERGE_FIXUP) { pg8::Unit fu; int lastpm = -1; for (int ui = 0; S.next(ui, fu); ++ui) if (fu.pm != lastpm) { fixup_panel(F, l, fu.pm); lastpm = fu.pm; } VM_WAIT(); __syncthreads(); }
            pg8::EpiResid E{(bf16*)(F.ws + WS_XB), ss3};
            pg8::gemm_phase<pg8::EpiResid, pg8::StaticOrder, ALIGN_RESID, PG8_SP2>(F.lds + RING_OFF, g, S, E, F.tid);
            if (BOTH(pb + 5)) SEAM();
        }
    }
    if (IN(NPHASE - 1)) { REFRESH(); } if (IN(NPHASE - 1)) phase_final(F, sumsq + (size_t)(2 * DEPTH) * T);
#undef IN
#undef BOTH
#undef SEAM
}

extern "C" void kernel_launch(void* const* d_in, const int* in_sizes, int n_in, void* d_out, int out_size, void* d_ws, size_t ws_size, hipStream_t stream) {
    static int grid = 0;
    if (grid == 0) {
        if (n_in != 14 || in_sizes[0] != T * DM || out_size != T * DM || ws_size < WS_END) { fprintf(stderr, "kernel_launch: unexpected shapes (n_in %d, in0 %d, out %d, ws %zu < %zu)\n", n_in, n_in > 0 ? in_sizes[0] : -1, out_size, ws_size, (size_t)WS_END); grid = -1; return; }
        int dev = 0, cus = 0, per_cu = 0;
        if (hipGetDevice(&dev) != hipSuccess || hipDeviceGetAttribute(&cus, hipDeviceAttributeMultiprocessorCount, dev) != hipSuccess) { grid = -1; return; }
        if (hipFuncSetAttribute((const void*)mk_fwd, hipFuncAttributeMaxDynamicSharedMemorySize, LDS_BYTES) != hipSuccess) { fprintf(stderr, "kernel_launch: hipFuncSetAttribute failed\n"); grid = -1; return; }
        if (hipOccupancyMaxActiveBlocksPerMultiprocessor(&per_cu, (const void*)mk_fwd, NTHREADS, LDS_BYTES) != hipSuccess || per_cu < 1) { fprintf(stderr, "kernel_launch: occupancy query says %d blocks per CU\n", per_cu); (void)hipGetLastError(); grid = -1; return; }
        grid = cus;
        if ((T * 12) % (grid * 4) != 0) { fprintf(stderr, "kernel_launch: grid %d does not divide the naive prep items\n", grid); grid = -1; return; }
    }
    if (grid < 0) return;
    if (hipMemsetAsync((char*)d_ws + WS_CTL, 0, CTL_ZERO_BYTES, stream) != hipSuccess) { fprintf(stderr, "kernel_launch: memset failed\n"); return; }
    Args a{};
    for (int i = 0; i < 14; ++i) a.in[i] = (const float*)d_in[i];
    a.out = (float*)d_out; a.ws = (unsigned char*)d_ws;
#if MK_SPLIT
    for (int ph = 0; ph < NPHASE; ++ph) { a.ph_lo = ph; a.ph_hi = ph + 1; hipLaunchKernelGGL(mk_fwd, dim3(grid), dim3(NTHREADS), LDS_BYTES, stream, a); }
#else
    a.ph_lo = 0; a.ph_hi = NPHASE;
    void* kargs[] = {&a};
    hipError_t e = hipLaunchCooperativeKernel((const void*)mk_fwd, dim3(grid), dim3(NTHREADS), kargs, LDS_BYTES, stream);
    if (e != hipSuccess) fprintf(stderr, "kernel_launch: cooperative launch failed: %s (grid %d)\n", hipGetErrorString(e), grid);
#endif
}
```
